# Optimizing an MI355X kernel written in HIP

```python
import math
import jax, jax.numpy as jnp
from jax import lax
import numpy as np

D_MODEL = 1024
BATCH = 8
SEQ = 2048
DEPTH = 4
DEC_BATCH = 16
DEC_SEQ = 2048
PAST_LEN = 128

MEM_LEN = 256
D_FF = 2816
C_A = D_MODEL // 2
A_GROUPS = 4
A_GROUP_DIM = C_A // A_GROUPS
C_B = D_MODEL - C_A
CONV_WIDTH = 31
CONV_PAD = (CONV_WIDTH - 1) // 2
AB_IN = C_A + 2 * C_B
MLA_HEADS = 8
QK_NOPE = 128
QK_ROPE = 64
V_DIM = 128
Q_LORA = 512
KV_LORA = 256
MLA_IN = Q_LORA + KV_LORA + QK_ROPE
ROPE_BASE = 10000.0
Q_BLOCK = 128
XA_HEADS = 4
XA_HEAD_DIM = D_MODEL // XA_HEADS
N_AB = (DEPTH + 1) // 2
N_MLA = DEPTH // 2
EPS = 1e-6

kernel_name = "hybrid_fnet_conv_mla_encoder"


def rms_norm(x, g):
    xf = x.astype(jnp.float32)
    y = xf * lax.rsqrt(jnp.mean(xf * xf, axis=-1, keepdims=True) + EPS)
    return (y * g.astype(jnp.float32)).astype(x.dtype)


def layer_norm(x, g, b):
    xf = x.astype(jnp.float32)
    mu = jnp.mean(xf, axis=-1, keepdims=True)
    xc = xf - mu
    var = jnp.mean(xc * xc, axis=-1, keepdims=True)
    y = xc * lax.rsqrt(var + EPS) * g.astype(jnp.float32) + b.astype(jnp.float32)
    return y.astype(x.dtype)


def swiglu(h, w_gate, w_up, w_down):
    return (jax.nn.silu(h @ w_gate) * (h @ w_up)) @ w_down


def rope_tables(seq):
    inv_freq = 1.0 / (ROPE_BASE ** (jnp.arange(0, QK_ROPE, 2, dtype=jnp.float32) / QK_ROPE))
    ang = jnp.arange(seq, dtype=jnp.float32)[:, None] * inv_freq[None, :]
    return jnp.cos(ang), jnp.sin(ang)


def apply_rope(x, cos, sin):
    half = x.shape[-1] // 2
    x1 = x[..., :half].astype(jnp.float32)
    x2 = x[..., half:].astype(jnp.float32)
    return jnp.concatenate([x1 * cos - x2 * sin, x1 * sin + x2 * cos], axis=-1).astype(x.dtype)


def fourier_mix(u):
    B, S, _ = u.shape
    uh = u.reshape(B, S, A_GROUPS, A_GROUP_DIM).astype(jnp.float32)
    y = jnp.fft.fft2(uh, axes=(1, 3), norm="ortho").real
    return y.reshape(B, S, C_A).astype(u.dtype)


def conv_module(u, conv_w, conv_b, ln_g, ln_b):
    a, g = u[..., :C_B], u[..., C_B:]
    h = a * jax.nn.sigmoid(g)
    h = lax.conv_general_dilated(
        h, conv_w[:, None, :].astype(h.dtype), window_strides=(1,),
        padding=[(CONV_PAD, CONV_PAD)], dimension_numbers=("NWC", "WIO", "NWC"),
        feature_group_count=C_B) + conv_b
    return jax.nn.silu(layer_norm(h, ln_g, ln_b))


def mixer_ab(h, w_in, conv_w, conv_b, ln_g, ln_b, w_out):
    u = h @ w_in
    ya = fourier_mix(u[..., :C_A])
    yb = conv_module(u[..., C_A:], conv_w, conv_b, ln_g, ln_b)
    return jnp.concatenate([ya, yb], axis=-1) @ w_out


def blocked_attention(q, k, v, scale):
    B, S, H, Dq = q.shape
    nb = S // Q_BLOCK
    qb = q.reshape(B, nb, Q_BLOCK, H, Dq).transpose(1, 0, 2, 3, 4)

    def one_block(qblk):
        s = jnp.einsum("bqhd,bkhd->bhqk", qblk, k).astype(jnp.float32) * scale
        p = jax.nn.softmax(s, axis=-1).astype(v.dtype)
        return jnp.einsum("bhqk,bkhd->bqhd", p, v)

    o = lax.map(one_block, qb)
    return o.transpose(1, 0, 2, 3, 4).reshape(B, S, H, v.shape[-1])


def mla(h, w_in, q_norm, w_q_b, kv_norm, w_kv_b, w_out, cos, sin):
    B, S, _ = h.shape
    u = h @ w_in
    cq = u[..., :Q_LORA]
    ckv = u[..., Q_LORA:Q_LORA + KV_LORA]
    kr = u[..., Q_LORA + KV_LORA:]
    q = (rms_norm(cq, q_norm) @ w_q_b).reshape(B, S, MLA_HEADS, QK_NOPE + QK_ROPE)
    q = jnp.concatenate([q[..., :QK_NOPE],
                         apply_rope(q[..., QK_NOPE:], cos[None, :, None, :], sin[None, :, None, :])], axis=-1)
    kv = (rms_norm(ckv, kv_norm) @ w_kv_b).reshape(B, S, MLA_HEADS, QK_NOPE + V_DIM)
    k_nope, v = kv[..., :QK_NOPE], kv[..., QK_NOPE:]
    kr = apply_rope(kr, cos[None], sin[None])
    k = jnp.concatenate([k_nope, jnp.broadcast_to(kr[:, :, None, :], (B, S, MLA_HEADS, QK_ROPE))], axis=-1)
    o = blocked_attention(q, k, v, 1.0 / math.sqrt(QK_NOPE + QK_ROPE))
    return o.reshape(B, S, MLA_HEADS * V_DIM) @ w_out


def cross_attn(h, m, w_q, w_kv, w_o):
    B, S, _ = h.shape
    M = m.shape[1]
    q = (h @ w_q).reshape(B, S, XA_HEADS, XA_HEAD_DIM)
    kv = (m @ w_kv).reshape(B, M, 2, XA_HEADS, XA_HEAD_DIM)
    k, v = kv[:, :, 0], kv[:, :, 1]
    s = jnp.einsum("bshd,bmhd->bhsm", q, k).astype(jnp.float32) * (1.0 / math.sqrt(XA_HEAD_DIM))
    p = jax.nn.softmax(s, axis=-1).astype(v.dtype)
    o = jnp.einsum("bhsm,bmhd->bshd", p, v).reshape(B, S, D_MODEL)
    return o @ w_o


def trunk(x, mem, p):
    cos, sin = rope_tables(x.shape[1])
    for l in range(DEPTH):
        h = rms_norm(x, p["ffn1_norm"][l])
        x = x + 0.5 * swiglu(h, p["ffn1_w_gate"][l], p["ffn1_w_up"][l], p["ffn1_w_down"][l])
        h = rms_norm(x, p["mix_norm"][l])
        i = l // 2
        if l % 2 == 0:
            x = x + mixer_ab(h, p["ab_w_in"][i], p["ab_conv_w"][i], p["ab_conv_b"][i],
                             p["ab_conv_ln_g"][i], p["ab_conv_ln_b"][i], p["ab_w_out"][i])
        else:
            x = x + mla(h, p["mla_w_in"][i], p["mla_q_norm"][i], p["mla_w_q_b"][i],
                        p["mla_kv_norm"][i], p["mla_w_kv_b"][i], p["mla_w_out"][i], cos, sin)
        h = rms_norm(x, p["xattn_norm"][l])
        m = rms_norm(mem, p["mem_norm"][l])
        x = x + cross_attn(h, m, p["xattn_w_q"][l], p["xattn_w_kv"][l], p["xattn_w_o"][l])
        h = rms_norm(x, p["ffn2_norm"][l])
        x = x + 0.5 * swiglu(h, p["ffn2_w_gate"][l], p["ffn2_w_up"][l], p["ffn2_w_down"][l])
    return rms_norm(x, p["final_norm"])


def _w(k, shape, fan_in):
    return jax.random.normal(k, shape, jnp.float32) * (fan_in ** -0.5)


def _gain(k, shape):
    return 1.0 + 0.01 * jax.random.normal(k, shape, jnp.float32)


def _small(k, shape):
    return 0.01 * jax.random.normal(k, shape, jnp.float32)


def setup_inputs(seed: int = 0) -> dict:
    key = jax.random.key(seed)
    ks = jax.random.split(key, 32)
    f32 = jnp.float32
    return {
        "x_prompt": jax.random.normal(ks[0], (BATCH, SEQ, D_MODEL), f32),
        "x_sample": jax.random.normal(ks[1], (DEC_BATCH, DEC_SEQ, D_MODEL), f32),
        "mem_prompt": jax.random.normal(ks[2], (BATCH, MEM_LEN, D_MODEL), f32),
        "mem_sample": jax.random.normal(ks[3], (DEC_BATCH, MEM_LEN, D_MODEL), f32),
        "ffn1_norm": _gain(ks[4], (DEPTH, D_MODEL)),
        "ffn1_w_gate": _w(ks[5], (DEPTH, D_MODEL, D_FF), D_MODEL),
        "ffn1_w_up": _w(ks[6], (DEPTH, D_MODEL, D_FF), D_MODEL),
        "ffn1_w_down": _w(ks[7], (DEPTH, D_FF, D_MODEL), D_FF),
        "mix_norm": _gain(ks[8], (DEPTH, D_MODEL)),
        "xattn_norm": _gain(ks[9], (DEPTH, D_MODEL)),
        "mem_norm": _gain(ks[10], (DEPTH, D_MODEL)),
        "xattn_w_q": _w(ks[11], (DEPTH, D_MODEL, D_MODEL), D_MODEL),
        "xattn_w_kv": _w(ks[12], (DEPTH, D_MODEL, 2 * D_MODEL), D_MODEL),
        "xattn_w_o": _w(ks[13], (DEPTH, D_MODEL, D_MODEL), D_MODEL),
        "ffn2_norm": _gain(ks[14], (DEPTH, D_MODEL)),
        "ffn2_w_gate": _w(ks[15], (DEPTH, D_MODEL, D_FF), D_MODEL),
        "ffn2_w_up": _w(ks[16], (DEPTH, D_MODEL, D_FF), D_MODEL),
        "ffn2_w_down": _w(ks[17], (DEPTH, D_FF, D_MODEL), D_FF),
        "ab_w_in": _w(ks[18], (N_AB, D_MODEL, AB_IN), D_MODEL),
        "ab_conv_w": _w(ks[19], (N_AB, CONV_WIDTH, C_B), CONV_WIDTH),
        "ab_conv_b": _small(ks[20], (N_AB, C_B)),
        "ab_conv_ln_g": _gain(ks[21], (N_AB, C_B)),
        "ab_conv_ln_b": _small(ks[22], (N_AB, C_B)),
        "ab_w_out": _w(ks[23], (N_AB, C_A + C_B, D_MODEL), C_A + C_B),
        "mla_w_in": _w(ks[24], (N_MLA, D_MODEL, MLA_IN), D_MODEL),
        "mla_q_norm": _gain(ks[25], (N_MLA, Q_LORA)),
        "mla_w_q_b": _w(ks[26], (N_MLA, Q_LORA, MLA_HEADS * (QK_NOPE + QK_ROPE)), Q_LORA),
        "mla_kv_norm": _gain(ks[27], (N_MLA, KV_LORA)),
        "mla_w_kv_b": _w(ks[28], (N_MLA, KV_LORA, MLA_HEADS * (QK_NOPE + V_DIM)), KV_LORA),
        "mla_w_out": _w(ks[29], (N_MLA, MLA_HEADS * V_DIM, D_MODEL), MLA_HEADS * V_DIM),
        "final_norm": _gain(ks[30], (D_MODEL,)),
    }


def reference(x_prompt, x_sample, mem_prompt, mem_sample,
              ffn1_norm, ffn1_w_gate, ffn1_w_up, ffn1_w_down,
              mix_norm, xattn_norm, mem_norm, xattn_w_q, xattn_w_kv, xattn_w_o,
              ffn2_norm, ffn2_w_gate, ffn2_w_up, ffn2_w_down,
              ab_w_in, ab_conv_w, ab_conv_b, ab_conv_ln_g, ab_conv_ln_b, ab_w_out,
              mla_w_in, mla_q_norm, mla_w_q_b, mla_kv_norm, mla_w_kv_b, mla_w_out,
              final_norm):
    p = {
        "ffn1_norm": ffn1_norm, "ffn1_w_gate": ffn1_w_gate, "ffn1_w_up": ffn1_w_up, "ffn1_w_down": ffn1_w_down,
        "mix_norm": mix_norm, "xattn_norm": xattn_norm, "mem_norm": mem_norm,
        "xattn_w_q": xattn_w_q, "xattn_w_kv": xattn_w_kv, "xattn_w_o": xattn_w_o,
        "ffn2_norm": ffn2_norm, "ffn2_w_gate": ffn2_w_gate, "ffn2_w_up": ffn2_w_up, "ffn2_w_down": ffn2_w_down,
        "ab_w_in": ab_w_in, "ab_conv_w": ab_conv_w, "ab_conv_b": ab_conv_b,
        "ab_conv_ln_g": ab_conv_ln_g, "ab_conv_ln_b": ab_conv_ln_b, "ab_w_out": ab_w_out,
        "mla_w_in": mla_w_in, "mla_q_norm": mla_q_norm, "mla_w_q_b": mla_w_q_b,
        "mla_kv_norm": mla_kv_norm, "mla_w_kv_b": mla_w_kv_b, "mla_w_out": mla_w_out,
        "final_norm": final_norm,
    }
    y_prompt = trunk(x_prompt, mem_prompt, p)
    y_sample = trunk(x_sample, mem_sample, p)
    return (y_prompt, y_sample)
```

```cpp
#include <hip/hip_runtime.h>
#include <hip/hip_cooperative_groups.h>
#include <cstdio>
#include <cstdint>
#include <utility>
namespace cg = cooperative_groups;

#ifndef MULTI_LAUNCH
#define MULTI_LAUNCH 0
#endif

#define DI __device__ __forceinline__
typedef unsigned short bf16_t;
using bf16x8 = __attribute__((ext_vector_type(8))) short;
using f32x16 = __attribute__((ext_vector_type(16))) float;
using u32x4 = __attribute__((ext_vector_type(4))) unsigned;
using u32x2 = __attribute__((ext_vector_type(2))) unsigned;
#define MFMA(a, b, c) __builtin_amdgcn_mfma_f32_32x32x16_bf16((a), (b), (c), 0, 0, 0)

constexpr int T = 49152, DM = 1024, FF = 2816, SEQ = 2048, NSEQ = 24, MEMT = 6144;
constexpr int HT = 24576;
constexpr float EPS = 1e-6f;
constexpr int NTHR = 256;
constexpr int LDS_BYTES = 73728;
constexpr int LDT = 72;
constexpr int LDC = 132;

constexpr size_t SZ_WGU = (size_t)5632 * 1024 * 2, SZ_WD = (size_t)1024 * 2816 * 2;
constexpr size_t OFF_WGU1 = 0, OFF_WD1 = OFF_WGU1 + SZ_WGU, OFF_WGU2 = OFF_WD1 + SZ_WD, OFF_WD2 = OFF_WGU2 + SZ_WGU;
constexpr size_t OFF_WXQ = OFF_WD2 + SZ_WD, OFF_WXKV = OFF_WXQ + 2097152, OFF_WXO = OFF_WXKV + 4194304;
constexpr size_t OFF_WMIX = OFF_WXO + 2097152;
constexpr size_t WM_ABIN = 0, WM_ABOUT = 4194304;
constexpr size_t WM_MLAIN = 0, WM_QB = 1835008, WM_KVB = 3407872, WM_MLAOUT = 4456448;
constexpr size_t OFF_DFT = OFF_WMIX + 6553600;
constexpr size_t OFF_ROPE = OFF_DFT + 16777216;
constexpr size_t OFF_SSQ = OFF_ROPE + 524288;
constexpr size_t OFF_MEMN = OFF_SSQ + (size_t)21 * T * 8 * 4;
constexpr size_t OFF_MEMK = OFF_MEMN + 12582912, OFF_MEMVT = OFF_MEMK + 12582912;
constexpr size_t OFF_XB = OFF_MEMVT + 12582912;
constexpr size_t OFF_R = OFF_XB + (size_t)T * 1024 * 2;
constexpr size_t WS_NEED = OFF_R + (size_t)T * 2816 * 2;
constexpr size_t R_PQT = 0, R_HCONV = 100663296, R_YAB = 150994944;
constexpr size_t R_U = 0, R_Q = 44040192, R_KN = 119537664, R_VT = 169869312, R_O = 220200960;
constexpr size_t R_QX = 0, R_OX = 100663296;

struct Params { const float* in[31]; float* out; unsigned char* ws; int pb, pe; };

DI unsigned short f2bf(float x) { unsigned u = __float_as_uint(x); u += 0x7fffu + ((u >> 16) & 1u); return (unsigned short)(u >> 16); }
DI unsigned pack2(float a, float b) { return (unsigned)f2bf(a) | ((unsigned)f2bf(b) << 16); }
DI int otid() { int t = threadIdx.x; asm volatile("" : "+v"(t)); return t; }
DI unsigned char* opq(unsigned char* p) { asm volatile("" : "+s"(p)); return p; }
DI float rstd8(const float* ssq, size_t row, float invd) {
  const float4 a = *(const float4*)(ssq + row * 8), b = *(const float4*)(ssq + row * 8 + 4);
  const float sm = ((a.x + a.y) + (a.z + a.w)) + ((b.x + b.y) + (b.z + b.w));
  return rsqrtf(sm * invd + EPS);
}
DI int crow(int i, int h) { return (i & 3) + 8 * (i >> 2) + 4 * h; }
DI float sigmoidf_(float x) { return 1.f / (1.f + __expf(-x)); }

DI void gemm_tile(const bf16_t* __restrict__ A, long lda, const bf16_t* __restrict__ Bt, long ldb, int K, unsigned char* smem) {
  bf16_t* sA = (bf16_t*)smem;
  bf16_t* sB = sA + 2 * 128 * LDT;
  float* sC = (float*)smem;
  const int tid = otid(), lane = tid & 63, wave = tid >> 6;
  const int wm = wave >> 1, wn = wave & 1, r = lane & 31, h = lane >> 5;
  const int lrow = tid >> 3, lkc = tid & 7;
  const bf16_t* gA = A + (long)lrow * lda + lkc * 8;
  const bf16_t* gB = Bt + (long)lrow * ldb + lkc * 8;
  u32x4 ra[4], rb[4];
  f32x16 acc[2][2];
#pragma unroll
  for (int a = 0; a < 2; ++a)
#pragma unroll
    for (int b = 0; b < 2; ++b)
#pragma unroll
      for (int i = 0; i < 16; ++i) acc[a][b][i] = 0.f;
  __syncthreads();
#pragma unroll
  for (int i = 0; i < 4; ++i) { ra[i] = *(const u32x4*)(gA + (long)(32 * i) * lda); rb[i] = *(const u32x4*)(gB + (long)(32 * i) * ldb); }
#pragma unroll
  for (int i = 0; i < 4; ++i) { *(u32x4*)(sA + (lrow + 32 * i) * LDT + lkc * 8) = ra[i]; *(u32x4*)(sB + (lrow + 32 * i) * LDT + lkc * 8) = rb[i]; }
  __syncthreads();
  const int nk = K >> 6;
  for (int kt = 0; kt < nk; ++kt) {
    const int cur = kt & 1;
    const bool more = (kt + 1 < nk);
    if (more) {
      gA += 64; gB += 64;
#pragma unroll
      for (int i = 0; i < 4; ++i) { ra[i] = *(const u32x4*)(gA + (long)(32 * i) * lda); rb[i] = *(const u32x4*)(gB + (long)(32 * i) * ldb); }
    }
    const bf16_t* cA = sA + cur * 128 * LDT + (wm * 64 + r) * LDT + h * 8;
    const bf16_t* cB = sB + cur * 128 * LDT + (wn * 64 + r) * LDT + h * 8;
#pragma unroll
    for (int ks = 0; ks < 4; ++ks) {
      bf16x8 a0 = *(const bf16x8*)(cA + ks * 16), a1 = *(const bf16x8*)(cA + 32 * LDT + ks * 16);
      bf16x8 b0 = *(const bf16x8*)(cB + ks * 16), b1 = *(const bf16x8*)(cB + 32 * LDT + ks * 16);
      acc[0][0] = MFMA(a0, b0, acc[0][0]); acc[0][1] = MFMA(a0, b1, acc[0][1]);
      acc[1][0] = MFMA(a1, b0, acc[1][0]); acc[1][1] = MFMA(a1, b1, acc[1][1]);
    }
    if (more) {
      bf16_t* dA = sA + (cur ^ 1) * 128 * LDT; bf16_t* dB = sB + (cur ^ 1) * 128 * LDT;
#pragma unroll
      for (int i = 0; i < 4; ++i) { *(u32x4*)(dA + (lrow + 32 * i) * LDT + lkc * 8) = ra[i]; *(u32x4*)(dB + (lrow + 32 * i) * LDT + lkc * 8) = rb[i]; }
    }
    __syncthreads();
  }
#pragma unroll
  for (int mi = 0; mi < 2; ++mi)
#pragma unroll
    for (int ni = 0; ni < 2; ++ni)
#pragma unroll
      for (int i = 0; i < 16; ++i) sC[(wm * 64 + mi * 32 + crow(i, h)) * LDC + wn * 64 + ni * 32 + r] = acc[mi][ni][i];
  __syncthreads();
}

enum { EPI_STORE = 0, EPI_RESID, EPI_SWIGLU, EPI_MLAIN, EPI_Q, EPI_KV, EPI_ABIN, EPI_MEMKV };
struct Epi { void* p0; void* p1; void* p2; const float* ssq; const float2* rope; float f0; float f1; int i0; int i1; };

DI void fill_rs(float* sRS, const float* ssq, int row0, float invd) {
  const int tid = otid();
  if (tid < 128) sRS[tid] = rstd8(ssq, (size_t)(row0 + tid), invd);
  __syncthreads();
}
DI void tstore(const float* sC, const float* sRS, bool use_rs, bf16_t* dst, long cstride) {
  const int tid = otid(), c = tid & 127, rg = tid >> 7;
#pragma unroll 1
  for (int q = 0; q < 8; ++q) {
    const int r0 = rg * 64 + q * 8;
    float v[8];
#pragma unroll
    for (int j = 0; j < 8; ++j) v[j] = sC[(r0 + j) * LDC + c] * (use_rs ? sRS[r0 + j] : 1.f);
    u32x4 pk = {pack2(v[0], v[1]), pack2(v[2], v[3]), pack2(v[4], v[5]), pack2(v[6], v[7])};
    *(u32x4*)(dst + (long)c * cstride + r0) = pk;
  }
}
DI void ld8(const float* p, float* v) { float4 a = *(const float4*)p, b = *(const float4*)(p + 4); v[0] = a.x; v[1] = a.y; v[2] = a.z; v[3] = a.w; v[4] = b.x; v[5] = b.y; v[6] = b.z; v[7] = b.w; }
DI u32x4 pk8(const float* v) { u32x4 pk = {pack2(v[0], v[1]), pack2(v[2], v[3]), pack2(v[4], v[5]), pack2(v[6], v[7])}; return pk; }
DI float red16(float s) { s += __shfl_xor(s, 1); s += __shfl_xor(s, 2); s += __shfl_xor(s, 4); s += __shfl_xor(s, 8); return s; }
DI void rope8(float* v, const float2* rope, int pos, int i0) {
#pragma unroll
  for (int j = 0; j < 4; ++j) { float2 cs = rope[pos * 32 + i0 + j]; float x1 = v[2 * j], x2 = v[2 * j + 1]; v[2 * j] = x1 * cs.x - x2 * cs.y; v[2 * j + 1] = x1 * cs.y + x2 * cs.x; }
}

template <int EPI>
DI void epilogue(const Epi& e, int row0, int tn, unsigned char* smem) {
  float* sC = (float*)smem;
  float* sRS = (float*)(smem + 128 * LDC * 4);
  const int tid = otid();
  if constexpr (EPI == EPI_RESID) {
    float* x = (float*)e.p0; bf16_t* xb = (bf16_t*)e.p1; float* ssqn = (float*)e.p2;
    const int er = tid >> 4, ec = (tid & 15) * 8;
#pragma unroll 1
    for (int p = 0; p < 8; ++p) {
      const int rl = er + 16 * p; const size_t row = (size_t)row0 + rl;
      float c[8], xv[8]; ld8(sC + rl * LDC + ec, c);
      float* xp = x + row * 1024 + tn * 128 + ec; ld8(xp, xv);
      float ss = 0.f;
#pragma unroll
      for (int j = 0; j < 8; ++j) { xv[j] += e.f0 * c[j]; ss += xv[j] * xv[j]; }
      *(float4*)xp = make_float4(xv[0], xv[1], xv[2], xv[3]); *(float4*)(xp + 4) = make_float4(xv[4], xv[5], xv[6], xv[7]);
      *(u32x4*)(xb + row * 1024 + tn * 128 + ec) = pk8(xv);
      ss = red16(ss);
      if ((tid & 15) == 0) ssqn[row * 8 + tn] = ss;
    }
  } else if constexpr (EPI == EPI_STORE) {
    bf16_t* out = (bf16_t*)e.p0; const int ldo = e.i0;
    const int er = tid >> 4, ec = (tid & 15) * 8;
#pragma unroll 1
    for (int p = 0; p < 8; ++p) {
      const int rl = er + 16 * p; const size_t row = (size_t)row0 + rl;
      float c[8]; ld8(sC + rl * LDC + ec, c);
      float rs = e.f0; if (e.ssq) rs *= rstd8(e.ssq, row, e.f1);
#pragma unroll
      for (int j = 0; j < 8; ++j) c[j] *= rs;
      *(u32x4*)(out + row * ldo + tn * 128 + ec) = pk8(c);
    }
  } else if constexpr (EPI == EPI_SWIGLU) {
    bf16_t* out = (bf16_t*)e.p0;
    const int er = tid >> 3, ec = (tid & 7) * 8;
#pragma unroll 1
    for (int p = 0; p < 4; ++p) {
      const int rl = er + 32 * p; const size_t row = (size_t)row0 + rl;
      float g[8], u[8]; ld8(sC + rl * LDC + ec, g); ld8(sC + rl * LDC + 64 + ec, u);
      const float rs = rstd8(e.ssq, row, e.f1);
#pragma unroll
      for (int j = 0; j < 8; ++j) { float gg = g[j] * rs, uu = u[j] * rs; g[j] = gg * sigmoidf_(gg) * uu; }
      *(u32x4*)(out + row * FF + tn * 64 + ec) = pk8(g);
    }
  } else if constexpr (EPI == EPI_MLAIN) {
    bf16_t* u = (bf16_t*)e.p0; float* ssq_q = (float*)e.p1; float* ssq_kv = (float*)e.p2;
    const int er = tid >> 4, ec = (tid & 15) * 8;
#pragma unroll 1
    for (int p = 0; p < 8; ++p) {
      const int rl = er + 16 * p; const size_t row = (size_t)row0 + rl;
      float c[8]; ld8(sC + rl * LDC + ec, c);
      const float rs = rstd8(e.ssq, row, e.f1);
      float ss = 0.f;
#pragma unroll
      for (int j = 0; j < 8; ++j) { c[j] *= rs; ss += c[j] * c[j]; }
      if (tn < 6) {
        ss = red16(ss);
        if ((tid & 15) == 0) { if (tn < 4) ssq_q[row * 8 + tn] = ss; else ssq_kv[row * 8 + tn - 4] = ss; }
      } else if (ec < 64) {
        rope8(c, e.rope, (int)(row & 2047), ec >> 1);
      }
      *(u32x4*)(u + row * 896 + tn * 128 + ec) = pk8(c);
    }
  } else if constexpr (EPI == EPI_Q) {
    bf16_t* q = (bf16_t*)e.p0;
    const int er = tid >> 4, ec = (tid & 15) * 8;
    const int col = tn * 128 + ec; const int cc = col % 192;
#pragma unroll 1
    for (int p = 0; p < 8; ++p) {
      const int rl = er + 16 * p; const size_t row = (size_t)row0 + rl;
      float c[8]; ld8(sC + rl * LDC + ec, c);
      const float rs = rstd8(e.ssq, row, e.f1);
#pragma unroll
      for (int j = 0; j < 8; ++j) c[j] *= rs;
      if (cc >= 128) rope8(c, e.rope, (int)(row & 2047), (cc - 128) >> 1);
#pragma unroll
      for (int j = 0; j < 8; ++j) c[j] *= e.f0;
      *(u32x4*)(q + row * 1536 + col) = pk8(c);
    }
  } else if constexpr (EPI == EPI_KV) {
    bf16_t* kn = (bf16_t*)e.p0; bf16_t* vT = (bf16_t*)e.p1;
    const int hh = tn >> 1;
    if ((tn & 1) == 0) {
      const int er = tid >> 4, ec = (tid & 15) * 8;
#pragma unroll 1
      for (int p = 0; p < 8; ++p) {
        const int rl = er + 16 * p; const size_t row = (size_t)row0 + rl;
        float c[8]; ld8(sC + rl * LDC + ec, c);
        const float rs = rstd8(e.ssq, row, e.f1);
#pragma unroll
        for (int j = 0; j < 8; ++j) c[j] *= rs;
        *(u32x4*)(kn + row * 1024 + hh * 128 + ec) = pk8(c);
      }
    } else {
      fill_rs(sRS, e.ssq, row0, e.f1);
      const int b = row0 >> 11, pos0 = row0 & 2047;
      tstore(sC, sRS, true, vT + ((size_t)(b * 8 + hh) * 128) * 2048 + pos0, 2048);
    }
  } else if constexpr (EPI == EPI_ABIN) {
    bf16_t* pqT = (bf16_t*)e.p0; bf16_t* hc = (bf16_t*)e.p1;
    if (tn < 8) {
      fill_rs(sRS, e.ssq, row0, e.f1);
      const int b = row0 >> 11, pos0 = row0 & 2047;
      tstore(sC, sRS, true, pqT + ((size_t)(b * 512 + (tn & 3) * 128)) * 4096 + (tn >> 2) * 2048 + pos0, 4096);
    } else {
      const int er = tid >> 3, ec = (tid & 7) * 8;
#pragma unroll 1
      for (int p = 0; p < 4; ++p) {
        const int rl = er + 32 * p; const size_t row = (size_t)row0 + rl;
        float a[8], g[8]; ld8(sC + rl * LDC + ec, a); ld8(sC + rl * LDC + 64 + ec, g);
        const float rs = rstd8(e.ssq, row, e.f1);
#pragma unroll
        for (int j = 0; j < 8; ++j) a[j] = a[j] * rs * sigmoidf_(g[j] * rs);
        *(u32x4*)(hc + row * 512 + (tn - 8) * 64 + ec) = pk8(a);
      }
    }
  } else if constexpr (EPI == EPI_MEMKV) {
    bf16_t* mk = (bf16_t*)e.p0; bf16_t* mvT = (bf16_t*)e.p1;
    if (tn < 8) {
      const int er = tid >> 4, ec = (tid & 15) * 8;
#pragma unroll 1
      for (int p = 0; p < 8; ++p) {
        const int rl = er + 16 * p; const size_t row = (size_t)row0 + rl;
        float c[8]; ld8(sC + rl * LDC + ec, c);
        *(u32x4*)(mk + row * 1024 + tn * 128 + ec) = pk8(c);
      }
    } else {
      const int t8 = tn - 8, hh = t8 >> 1, d0 = (t8 & 1) * 128;
      const int b = row0 >> 8, m0 = row0 & 255;
      tstore(sC, sRS, false, mvT + ((size_t)(b * 4 + hh) * 256 + d0) * 256 + m0, 256);
    }
  }
}

template <int EPI>
DI void gemm_job(const bf16_t* A, long lda, long sAz, const bf16_t* B, long ldb, long sBz, int nz, int mt, int nt, int K, const Epi& e, unsigned char* smem, int shift) {
  const int G = gridDim.x;
  const int total = nz * mt * nt, per = mt * nt;
  for (int u = (int)((blockIdx.x + G - (shift % G)) % G); u < total; u += G) {
    const int z = u / per; const int rem = u - z * per; const int tm = rem / nt; const int tn = rem - tm * nt;
    gemm_tile(A + (size_t)z * sAz + (size_t)tm * 128 * lda, lda, B + (size_t)z * sBz + (size_t)tn * 128 * ldb, ldb, K, smem);
    epilogue<EPI>(e, (z * mt + tm) * 128, tn, smem);
  }
}

template <int DQK, int K0C, int DVC>
DI void attn_unit(const bf16_t* __restrict__ q, long ldq, const bf16_t* __restrict__ k0, long ldk0, const bf16_t* __restrict__ k1, long ldk1,
                  const bf16_t* __restrict__ vt, long ldvt, int nkeys, bf16_t* __restrict__ o, long ldo, unsigned char* smem) {
  constexpr int LDK = DQK + 8, CPR = DQK / 8, NKS = DQK / 16, ND = DVC / 32;
  bf16_t* sK = (bf16_t*)smem; bf16_t* sV = sK + 64 * LDK;
  const int tid = otid(), lane = tid & 63, w = tid >> 6, r = lane & 31, h = lane >> 5;
  bf16x8 bq[NKS];
  {
    const bf16_t* qp = q + (long)(w * 32 + r) * ldq + h * 8;
#pragma unroll
    for (int ks = 0; ks < NKS; ++ks) bq[ks] = *(const bf16x8*)(qp + ks * 16);
  }
  f32x16 oacc[ND];
#pragma unroll
  for (int d = 0; d < ND; ++d)
#pragma unroll
    for (int i = 0; i < 16; ++i) oacc[d][i] = 0.f;
  float m_run = -1e30f, l_run = 0.f;
  for (int key0 = 0; key0 < nkeys; key0 += 64) {
    __syncthreads();
#pragma unroll
    for (int it = 0; it < (64 * CPR) / 256; ++it) {
      const int c = tid + 256 * it; const int row = c / CPR; const int col = (c - row * CPR) * 8;
      const bf16_t* src = (col < K0C) ? (k0 + (long)(key0 + row) * ldk0 + col) : (k1 + (long)(key0 + row) * ldk1 + (col - K0C));
      *(u32x4*)(sK + row * LDK + col) = *(const u32x4*)src;
      if ((it & 1) == 1) __builtin_amdgcn_sched_barrier(0);
    }
    __builtin_amdgcn_sched_barrier(0);
#pragma unroll
    for (int it = 0; it < DVC / 32; ++it) {
      const int c = tid + 256 * it; const int row = c >> 3, kc = c & 7;
      *(u32x4*)(sV + row * 72 + kc * 8) = *(const u32x4*)(vt + (long)row * ldvt + key0 + kc * 8);
      if ((it & 1) == 1) __builtin_amdgcn_sched_barrier(0);
    }
    __syncthreads();
    __builtin_amdgcn_sched_barrier(0);
    f32x16 st[2];
#pragma unroll
    for (int i = 0; i < 16; ++i) { st[0][i] = 0.f; st[1][i] = 0.f; }
    const bf16_t* kp = sK + r * LDK + h * 8;
#pragma unroll
    for (int ks = 0; ks < NKS; ++ks) {
      bf16x8 a0 = *(const bf16x8*)(kp + ks * 16), a1 = *(const bf16x8*)(kp + 32 * LDK + ks * 16);
      st[0] = MFMA(a0, bq[ks], st[0]); st[1] = MFMA(a1, bq[ks], st[1]);
    }
    __builtin_amdgcn_sched_barrier(0);
    float mx = st[0][0];
#pragma unroll
    for (int i = 0; i < 16; ++i) { mx = fmaxf(mx, st[0][i]); mx = fmaxf(mx, st[1][i]); }
    mx = fmaxf(mx, __shfl_xor(mx, 32));
    const float m_new = fmaxf(m_run, mx);
    const float alpha = __builtin_amdgcn_exp2f(m_run - m_new);
    m_run = m_new;
    float ls = 0.f;
#pragma unroll
    for (int i = 0; i < 16; ++i) { st[0][i] = __builtin_amdgcn_exp2f(st[0][i] - m_new); st[1][i] = __builtin_amdgcn_exp2f(st[1][i] - m_new); ls += st[0][i] + st[1][i]; }
    l_run = l_run * alpha + ls;
#pragma unroll
    for (int d = 0; d < ND; ++d)
#pragma unroll
      for (int i = 0; i < 16; ++i) oacc[d][i] *= alpha;
    __builtin_amdgcn_sched_barrier(0);
#pragma unroll
    for (int s = 0; s < 4; ++s) {
      const int mi = s >> 1, sub = s & 1;
      u32x4 pp = {pack2(st[mi][8 * sub + 0], st[mi][8 * sub + 1]), pack2(st[mi][8 * sub + 2], st[mi][8 * sub + 3]),
                  pack2(st[mi][8 * sub + 4], st[mi][8 * sub + 5]), pack2(st[mi][8 * sub + 6], st[mi][8 * sub + 7])};
      const bf16x8 pb = __builtin_bit_cast(bf16x8, pp);
#pragma unroll
      for (int d = 0; d < ND; ++d) {
        const bf16_t* vp = sV + (d * 32 + r) * 72 + s * 16 + 4 * h;
        u32x2 lo = *(const u32x2*)vp, hi = *(const u32x2*)(vp + 8);
        u32x4 av = {lo[0], lo[1], hi[0], hi[1]};
        oacc[d] = MFMA(__builtin_bit_cast(bf16x8, av), pb, oacc[d]);
      }
    }
  }
  const float l_tot = l_run + __shfl_xor(l_run, 32);
  const float inv = 1.f / l_tot;
  bf16_t* op = o + (long)(w * 32 + r) * ldo;
#pragma unroll
  for (int d = 0; d < ND; ++d)
#pragma unroll
    for (int g = 0; g < 4; ++g) {
      u32x2 pk = {pack2(oacc[d][4 * g] * inv, oacc[d][4 * g + 1] * inv), pack2(oacc[d][4 * g + 2] * inv, oacc[d][4 * g + 3] * inv)};
      *(u32x2*)(op + d * 32 + 8 * g + 4 * h) = pk;
    }
}

template <int RR>
DI void conv_step(float2 (&v)[8], const float2 (&wv)[31], const unsigned* sp) {
  const unsigned xx = sp[RR * 256];
  const float x0 = __uint_as_float(xx << 16), x1 = __uint_as_float(xx & 0xffff0000u);
#pragma unroll
  for (int t = 0; t < 8; ++t) {
    const int j = RR - t;
    if (j >= 0 && j < 31) { v[t].x += wv[j].x * x0; v[t].y += wv[j].y * x1; }
  }
  if constexpr ((RR & 3) == 3) __builtin_amdgcn_sched_barrier(0);
}
template <int... RR>
DI void conv_all(float2 (&v)[8], const float2 (&wv)[31], const unsigned* sp, std::integer_sequence<int, RR...>) { (conv_step<RR>(v, wv, sp), ...); }

DI void conv_unit(const bf16_t* __restrict__ hc, const float* __restrict__ cw, const float* __restrict__ cb, const float* __restrict__ lg, const float* __restrict__ lb,
                  bf16_t* __restrict__ yab, int b, int jt, unsigned char* smem) {
  bf16_t* sH = (bf16_t*)smem;
  float* sRed = (float*)(smem + 62 * 512 * 2);
  const int tid = otid(), lane = tid & 63, w = tid >> 6;
  __syncthreads();
  for (int c = tid; c < 62 * 64; c += 256) {
    const int row = c >> 6, kc = c & 63; const int pos = jt * 32 - 15 + row;
    u32x4 v = {0u, 0u, 0u, 0u};
    if (pos >= 0 && pos < SEQ) v = *(const u32x4*)(hc + ((size_t)b * SEQ + pos) * 512 + kc * 8);
    *(u32x4*)(sH + row * 512 + kc * 8) = v;
  }
  float2 wv[31];
#pragma unroll
  for (int j = 0; j < 31; ++j) wv[j] = *(const float2*)(cw + j * 512 + 2 * tid);
  const float2 bias = *(const float2*)(cb + 2 * tid);
  const float2 g2 = *(const float2*)(lg + 2 * tid), b2 = *(const float2*)(lb + 2 * tid);
  __syncthreads();
  const unsigned* sH32 = (const unsigned*)sH;
#pragma unroll 1
  for (int tg = 0; tg < 4; ++tg) {
    float2 v[8];
#pragma unroll
    for (int t = 0; t < 8; ++t) v[t] = bias;
    conv_all(v, wv, sH32 + tg * 8 * 256 + tid, std::make_integer_sequence<int, 38>{});
#pragma unroll
    for (int t = 0; t < 8; ++t) {
      float s1 = v[t].x + v[t].y, s2 = v[t].x * v[t].x + v[t].y * v[t].y;
#pragma unroll
      for (int m = 1; m < 64; m <<= 1) { s1 += __shfl_xor(s1, m); s2 += __shfl_xor(s2, m); }
      if (lane == 0) { sRed[((tg * 4 + w) * 8 + t) * 2] = s1; sRed[((tg * 4 + w) * 8 + t) * 2 + 1] = s2; }
    }
    __syncthreads();
#pragma unroll
    for (int t = 0; t < 8; ++t) {
      float s1 = 0.f, s2 = 0.f;
#pragma unroll
      for (int ww = 0; ww < 4; ++ww) { s1 += sRed[((tg * 4 + ww) * 8 + t) * 2]; s2 += sRed[((tg * 4 + ww) * 8 + t) * 2 + 1]; }
      const float mean = s1 * (1.f / 512.f); const float var = fmaxf(s2 * (1.f / 512.f) - mean * mean, 0.f);
      const float rs = rsqrtf(var + EPS);
      float y0 = (v[t].x - mean) * rs * g2.x + b2.x, y1 = (v[t].y - mean) * rs * g2.y + b2.y;
      y0 = y0 * sigmoidf_(y0); y1 = y1 * sigmoidf_(y1);
      *(unsigned*)(yab + ((size_t)b * SEQ + jt * 32 + tg * 8 + t) * 1024 + 512 + 2 * tid) = pack2(y0, y1);
    }
  }
}

enum { WM_ID = 0, WM_GLU, WM_MLAINP, WM_QBP };
DI void wconv_job(const float* __restrict__ src0, const float* __restrict__ src1, int lds_, const float* __restrict__ g, bf16_t* __restrict__ dst, int Nd, int K, int mode,
                  unsigned char* smem, int shift) {
  float* sT = (float*)smem;
  const int G = gridDim.x;
  const int kt_n = K >> 6; const int total = (Nd >> 6) * kt_n;
  for (int u = (int)((blockIdx.x + G - (shift % G)) % G); u < total; u += G) {
    const int tid = otid();
    const int tnn = u / kt_n, tk = u - tnn * kt_n;
    const int n = tnn * 64 + (tid & 63);
    const float* sp = src0; int sc = n;
    if (mode == WM_GLU) { const int tl = n >> 7, i = n & 127; if (i < 64) sc = tl * 64 + i; else { sc = tl * 64 + i - 64; sp = src1; } }
    else if (mode == WM_MLAINP) { if (n >= 832) sc = -1; else if (n >= 768) { const int p = n - 768; sc = 768 + (p >> 1) + (p & 1) * 32; } }
    else if (mode == WM_QBP) { const int hh = n / 192, c = n - hh * 192; if (c >= 128) { const int p = c - 128; sc = hh * 192 + 128 + (p >> 1) + (p & 1) * 32; } }
    __syncthreads();
#pragma unroll 4
    for (int i = 0; i < 16; ++i) {
      const int kl = (tid >> 6) + 4 * i; const int k = tk * 64 + kl;
      float v = 0.f;
      if (sc >= 0) { v = sp[(size_t)k * lds_ + sc]; if (g) v *= g[k]; }
      sT[kl * 65 + (tid & 63)] = v;
    }
    __syncthreads();
    const int nl = tid >> 2, kc = (tid & 3) * 16;
    float v[16];
#pragma unroll
    for (int j = 0; j < 16; ++j) v[j] = sT[(kc + j) * 65 + nl];
    bf16_t* dp = dst + (size_t)(tnn * 64 + nl) * K + tk * 64 + kc;
    *(u32x4*)dp = pk8(v); *(u32x4*)(dp + 8) = pk8(v + 8);
  }
}
DI void wpq_job(const float* __restrict__ win, const float* __restrict__ gm, bf16_t* __restrict__ dst, unsigned char* smem) {
  float* sW = (float*)smem;
  float* tab = sW + 64 * 129;
  const int G = gridDim.x;
  for (int u = blockIdx.x; u < 64; u += G) {
    const int tid = otid();
    const int kt = u >> 2, gq = u & 3;
    __syncthreads();
    if (tid < 128) tab[tid] = cosf(6.283185307179586f * (float)tid / 128.f);
    for (int c = tid; c < 64 * 128; c += 256) { const int kk = c >> 7, cc = c & 127; sW[kk * 129 + cc] = win[(size_t)(kt * 64 + kk) * 1536 + gq * 128 + cc]; }
    __syncthreads();
    const int kk = tid & 63; const float gk = gm[kt * 64 + kk];
    for (int i = 0; i < 32; ++i) {
      const int j = (tid >> 6) + 4 * i;
      float p = 0.f, qv = 0.f;
      for (int c = 0; c < 128; ++c) { const float wv = sW[kk * 129 + c]; const int m = (c * j) & 127; p += wv * tab[m]; qv += wv * tab[(m - 32) & 127]; }
      dst[(size_t)(gq * 128 + j) * 1024 + kt * 64 + kk] = f2bf(p * gk);
      dst[(size_t)(512 + gq * 128 + j) * 1024 + kt * 64 + kk] = f2bf(qv * gk);
    }
  }
}

__global__ void __launch_bounds__(NTHR, 2) fwd_kernel(Params P) {
  extern __shared__ __attribute__((aligned(16))) unsigned char smem[];
  cg::grid_group grid = cg::this_grid();
  const int G = gridDim.x, bid = blockIdx.x;
  const int pb = P.pb, pe = P.pe;
#define X (Xo)
#define XB ((bf16_t*)(wsb + OFF_XB))
#define SSQ ((float*)(wsb + OFF_SSQ))
#define ROPE ((const float2*)(wsb + OFF_ROPE))
#define DFT ((bf16_t*)(wsb + OFF_DFT))
#define MEMN ((bf16_t*)(wsb + OFF_MEMN))
#define MEMK ((bf16_t*)(wsb + OFF_MEMK))
#define MEMVT ((bf16_t*)(wsb + OFF_MEMVT))
#define R (wsb + OFF_R)
#define WGU1 ((bf16_t*)(wsb + OFF_WGU1))
#define WD1 ((bf16_t*)(wsb + OFF_WD1))
#define WGU2 ((bf16_t*)(wsb + OFF_WGU2))
#define WD2 ((bf16_t*)(wsb + OFF_WD2))
#define WXQ ((bf16_t*)(wsb + OFF_WXQ))
#define WXKV ((bf16_t*)(wsb + OFF_WXKV))
#define WXO ((bf16_t*)(wsb + OFF_WXO))
#define WMIX (wsb + OFF_WMIX)
  int ph = 0;
#define PH_BEGIN if (ph >= pb && ph < pe) { unsigned char* wsb = opq(P.ws); float* Xo = (float*)opq((unsigned char*)P.out); const int tid = otid(); const int lane = tid & 63; (void)lane; (void)Xo; (void)wsb;
#define PH_END } ++ph; if (ph > pb && ph < pe) grid.sync();

  for (int l = 0; l < 4; ++l) {
    const int li = l >> 1; const bool even = ((l & 1) == 0);
    PH_BEGIN
      if (even) wpq_job(P.in[18] + (size_t)li * 1024 * 1536, P.in[8] + l * 1024, (bf16_t*)(WMIX + WM_ABIN), smem);
      if (l == 0) {
        const int wv = tid >> 6;
        for (int row = bid * 4 + wv; row < T; row += G * 4) {
          const float* src = (row < 16384) ? (P.in[0] + (size_t)row * 1024) : (P.in[1] + (size_t)(row - 16384) * 1024);
          float ss = 0.f;
#pragma unroll
          for (int i = 0; i < 4; ++i) {
            const int c = (i * 64 + lane) * 4;
            float4 v = *(const float4*)(src + c);
            *(float4*)(X + (size_t)row * 1024 + c) = v;
            u32x2 pk = {pack2(v.x, v.y), pack2(v.z, v.w)};
            *(u32x2*)(XB + (size_t)row * 1024 + c) = pk;
            ss += v.x * v.x + v.y * v.y + v.z * v.z + v.w * v.w;
          }
#pragma unroll
          for (int m = 1; m < 64; m <<= 1) ss += __shfl_xor(ss, m);
          if (lane < 8) SSQ[(size_t)row * 8 + lane] = (lane == 0) ? ss : 0.f;
        }
        for (size_t i = (size_t)bid * 256 + tid; i < (size_t)4 * T * 8; i += (size_t)G * 256) SSQ[(size_t)17 * T * 8 + i] = 0.f;
        for (int row = bid * 4 + wv; row < MEMT; row += G * 4) {
          const float* src = (row < 2048) ? (P.in[2] + (size_t)row * 1024) : (P.in[3] + (size_t)(row - 2048) * 1024);
          float4 v[4]; float ss = 0.f;
#pragma unroll
          for (int i = 0; i < 4; ++i) { v[i] = *(const float4*)(src + (i * 64 + lane) * 4); ss += v[i].x * v[i].x + v[i].y * v[i].y + v[i].z * v[i].z + v[i].w * v[i].w; }
#pragma unroll
          for (int m = 1; m < 64; m <<= 1) ss += __shfl_xor(ss, m);
          const float rs = rsqrtf(ss * (1.f / 1024.f) + EPS);
#pragma unroll
          for (int i = 0; i < 4; ++i) { u32x2 pk = {pack2(v[i].x * rs, v[i].y * rs), pack2(v[i].z * rs, v[i].w * rs)}; *(u32x2*)(MEMN + (size_t)row * 1024 + (i * 64 + lane) * 4) = pk; }
        }
        for (int i = bid * 256 + tid; i < 2048 * 32; i += G * 256) {
          const int pos = i >> 5, fi = i & 31;
          const float inv_freq = 1.0f / powf(10000.0f, (float)(2 * fi) / 64.0f);
          const float ang = (float)pos * inv_freq;
          ((float2*)(wsb + OFF_ROPE))[i] = make_float2(cosf(ang), sinf(ang));
        }
        for (size_t i = (size_t)bid * 256 + tid; i < (size_t)2048 * 2048; i += (size_t)G * 256) {
          const int s = (int)(i >> 11), t = (int)(i & 2047);
          const int m = (s * t) & 2047;
          const float ang = 6.283185307179586f * (float)m / 2048.f;
          DFT[(size_t)s * 4096 + t] = f2bf(cosf(ang));
          DFT[(size_t)s * 4096 + 2048 + t] = f2bf(-sinf(ang));
        }
      }
      {
        const size_t o_gu = (size_t)l * 1024 * 2816, o_sq = (size_t)l * 1024 * 1024;
        wconv_job(P.in[5] + o_gu, P.in[6] + o_gu, 2816, P.in[4] + l * 1024, WGU1, 5632, 1024, WM_GLU, smem, 64);
        wconv_job(P.in[7] + o_gu, nullptr, 1024, nullptr, WD1, 1024, 2816, WM_ID, smem, 64 + 1408);
        wconv_job(P.in[15] + o_gu, P.in[16] + o_gu, 2816, P.in[14] + l * 1024, WGU2, 5632, 1024, WM_GLU, smem, 64 + 2112);
        wconv_job(P.in[17] + o_gu, nullptr, 1024, nullptr, WD2, 1024, 2816, WM_ID, smem, 64 + 3520);
        wconv_job(P.in[11] + o_sq, nullptr, 1024, P.in[9] + l * 1024, WXQ, 1024, 1024, WM_ID, smem, 64 + 4224);
        wconv_job(P.in[12] + 2 * o_sq, nullptr, 2048, P.in[10] + l * 1024, WXKV, 2048, 1024, WM_ID, smem, 64 + 4480);
        wconv_job(P.in[13] + o_sq, nullptr, 1024, nullptr, WXO, 1024, 1024, WM_ID, smem, 64 + 4992);
        if (even) {
          const float* win = P.in[18] + (size_t)li * 1024 * 1536;
          wconv_job(win + 512, win + 1024, 1536, P.in[8] + l * 1024, (bf16_t*)(WMIX + WM_ABIN) + (size_t)1024 * 1024, 1024, 1024, WM_GLU, smem, 64 + 5248);
          wconv_job(P.in[23] + (size_t)li * 1024 * 1024, nullptr, 1024, nullptr, (bf16_t*)(WMIX + WM_ABOUT), 1024, 1024, WM_ID, smem, 64 + 5504);
        } else {
          wconv_job(P.in[24] + (size_t)li * 1024 * 832, nullptr, 832, P.in[8] + l * 1024, (bf16_t*)(WMIX + WM_MLAIN), 896, 1024, WM_MLAINP, smem, 64 + 5248);
          wconv_job(P.in[26] + (size_t)li * 512 * 1536, nullptr, 1536, P.in[25] + li * 512, (bf16_t*)(WMIX + WM_QB), 1536, 512, WM_QBP, smem, 64 + 5472);
          wconv_job(P.in[28] + (size_t)li * 256 * 2048, nullptr, 2048, P.in[27] + li * 256, (bf16_t*)(WMIX + WM_KVB), 2048, 256, WM_ID, smem, 64 + 5664);
          wconv_job(P.in[29] + (size_t)li * 1024 * 1024, nullptr, 1024, nullptr, (bf16_t*)(WMIX + WM_MLAOUT), 1024, 1024, WM_ID, smem, 64 + 5792);
        }
      }
    PH_END

    PH_BEGIN
      { Epi e{}; e.p0 = R; e.ssq = SSQ + (size_t)(4 * l + 0) * T * 8; e.f1 = 1.f / 1024.f;
        gemm_job<EPI_SWIGLU>(XB, 1024, 0, WGU1, 1024, 0, 1, T / 128, 44, 1024, e, smem, 0); }
      { Epi e{}; e.p0 = MEMK; e.p1 = MEMVT;
        gemm_job<EPI_MEMKV>(MEMN, 1024, 0, WXKV, 1024, 0, 1, MEMT / 128, 16, 1024, e, smem, (T / 128) * 44); }
    PH_END
    PH_BEGIN
      { Epi e{}; e.p0 = X; e.p1 = XB; e.p2 = SSQ + (size_t)(4 * l + 1) * T * 8; e.f0 = 0.5f;
        gemm_job<EPI_RESID>((const bf16_t*)R, FF, 0, WD1, FF, 0, 1, T / 128, 8, FF, e, smem, 0); }
    PH_END

    if (even) {
#define PQT ((bf16_t*)(R + R_PQT))
#define HC ((bf16_t*)(R + R_HCONV))
#define YAB ((bf16_t*)(R + R_YAB))
      PH_BEGIN
        { Epi e{}; e.p0 = PQT; e.p1 = HC; e.ssq = SSQ + (size_t)(4 * l + 1) * T * 8; e.f1 = 1.f / 1024.f;
          gemm_job<EPI_ABIN>(XB, 1024, 0, (const bf16_t*)(WMIX + WM_ABIN), 1024, 0, 1, T / 128, 16, 1024, e, smem, 0); }
      PH_END
      PH_BEGIN
        { Epi e{}; e.p0 = YAB; e.i0 = 1024; e.ssq = nullptr; e.f0 = 1.f / 512.f;
          gemm_job<EPI_STORE>(DFT, 4096, 0, PQT, 4096, (long)512 * 4096, NSEQ, 16, 4, 4096, e, smem, 0); }
        {
          const float* cw = P.in[19] + (size_t)li * 31 * 512; const float* cb = P.in[20] + li * 512;
          const float* lg = P.in[21] + li * 512; const float* lb = P.in[22] + li * 512;
          for (int u = bid; u < NSEQ * 64; u += G) conv_unit(HC, cw, cb, lg, lb, YAB, u >> 6, u & 63, smem);
        }
      PH_END
      PH_BEGIN
        { Epi e{}; e.p0 = X; e.p1 = XB; e.p2 = SSQ + (size_t)(4 * l + 2) * T * 8; e.f0 = 1.f;
          gemm_job<EPI_RESID>(YAB, 1024, 0, (const bf16_t*)(WMIX + WM_ABOUT), 1024, 0, 1, T / 128, 8, 1024, e, smem, 0); }
      PH_END
    } else {
#define U ((bf16_t*)(R + R_U))
#define Q ((bf16_t*)(R + R_Q))
#define KN ((bf16_t*)(R + R_KN))
#define VT ((bf16_t*)(R + R_VT))
#define O ((bf16_t*)(R + R_O))
#define SQQ (SSQ + (size_t)(17 + 2 * li) * T * 8)
#define SQKV (SSQ + (size_t)(18 + 2 * li) * T * 8)
      for (int hf = 0; hf < 2; ++hf) {
        const size_t ro = (size_t)hf * HT;
        PH_BEGIN
          { Epi e{}; e.p0 = U; e.p1 = SQQ + ro * 8; e.p2 = SQKV + ro * 8; e.ssq = SSQ + (size_t)(4 * l + 1) * T * 8 + ro * 8; e.f1 = 1.f / 1024.f; e.rope = ROPE;
            gemm_job<EPI_MLAIN>(XB + ro * 1024, 1024, 0, (const bf16_t*)(WMIX + WM_MLAIN), 1024, 0, 1, HT / 128, 7, 1024, e, smem, 0); }
        PH_END
        PH_BEGIN
          { Epi e{}; e.p0 = Q; e.ssq = SQQ + ro * 8; e.f1 = 1.f / 512.f; e.f0 = 1.4426950408889634f * 0.07216878364870322f; e.rope = ROPE;
            gemm_job<EPI_Q>(U, 896, 0, (const bf16_t*)(WMIX + WM_QB), 512, 0, 1, HT / 128, 12, 512, e, smem, 0); }
          { Epi e{}; e.p0 = KN; e.p1 = VT; e.ssq = SQKV + ro * 8; e.f1 = 1.f / 256.f;
            gemm_job<EPI_KV>(U + 512, 896, 0, (const bf16_t*)(WMIX + WM_KVB), 256, 0, 1, HT / 128, 16, 256, e, smem, (HT / 128) * 12); }
        PH_END
        PH_BEGIN
          for (int u = bid; u < 12 * 8 * 16; u += G) {
            const int qt = u & 15, hh = (u >> 4) & 7, b = u >> 7;
            attn_unit<192, 128, 128>(Q + ((size_t)b * 2048 + qt * 128) * 1536 + hh * 192, 1536,
                                KN + (size_t)b * 2048 * 1024 + hh * 128, 1024, U + (size_t)b * 2048 * 896 + 768, 896,
                                VT + ((size_t)(b * 8 + hh) * 128) * 2048, 2048, 2048,
                                O + ((size_t)b * 2048 + qt * 128) * 1024 + hh * 128, 1024, smem);
          }
        PH_END
        PH_BEGIN
          { Epi e{}; e.p0 = X + ro * 1024; e.p1 = XB + ro * 1024; e.p2 = SSQ + (size_t)(4 * l + 2) * T * 8 + ro * 8; e.f0 = 1.f;
            gemm_job<EPI_RESID>(O, 1024, 0, (const bf16_t*)(WMIX + WM_MLAOUT), 1024, 0, 1, HT / 128, 8, 1024, e, smem, 0); }
        PH_END
      }
    }

    {
#define QX ((bf16_t*)(R + R_QX))
#define OX ((bf16_t*)(R + R_OX))
      PH_BEGIN
        { Epi e{}; e.p0 = QX; e.i0 = 1024; e.ssq = SSQ + (size_t)(4 * l + 2) * T * 8; e.f1 = 1.f / 1024.f; e.f0 = 1.4426950408889634f * 0.0625f;
          gemm_job<EPI_STORE>(XB, 1024, 0, WXQ, 1024, 0, 1, T / 128, 8, 1024, e, smem, 0); }
      PH_END
      PH_BEGIN
        for (int u = bid; u < NSEQ * 4 * 4 * 16; u += G) {
          const int qt = u & 15, dvc = (u >> 4) & 3, hh = (u >> 6) & 3, b = u >> 8;
          attn_unit<256, 256, 64>(QX + ((size_t)b * 2048 + qt * 128) * 1024 + hh * 256, 1024,
                              MEMK + (size_t)b * 256 * 1024 + hh * 256, 1024, nullptr, 0,
                              MEMVT + ((size_t)(b * 4 + hh) * 256 + dvc * 64) * 256, 256, 256,
                              OX + ((size_t)b * 2048 + qt * 128) * 1024 + hh * 256 + dvc * 64, 1024, smem);
        }
      PH_END
      PH_BEGIN
        { Epi e{}; e.p0 = X; e.p1 = XB; e.p2 = SSQ + (size_t)(4 * l + 3) * T * 8; e.f0 = 1.f;
          gemm_job<EPI_RESID>(OX, 1024, 0, WXO, 1024, 0, 1, T / 128, 8, 1024, e, smem, 0); }
      PH_END
    }
    PH_BEGIN
      { Epi e{}; e.p0 = R; e.ssq = SSQ + (size_t)(4 * l + 3) * T * 8; e.f1 = 1.f / 1024.f;
        gemm_job<EPI_SWIGLU>(XB, 1024, 0, WGU2, 1024, 0, 1, T / 128, 44, 1024, e, smem, 0); }
    PH_END
    PH_BEGIN
      { Epi e{}; e.p0 = X; e.p1 = XB; e.p2 = SSQ + (size_t)(4 * l + 4) * T * 8; e.f0 = 0.5f;
        gemm_job<EPI_RESID>((const bf16_t*)R, FF, 0, WD2, FF, 0, 1, T / 128, 8, FF, e, smem, 0); }
    PH_END
  }
  PH_BEGIN
    {
      const int wv = tid >> 6; const float* fg = P.in[30]; const float* sq = SSQ + (size_t)16 * T * 8;
      for (int row = bid * 4 + wv; row < T; row += G * 4) {
        const float rs = rstd8(sq, (size_t)row, 1.f / 1024.f);
#pragma unroll
        for (int i = 0; i < 4; ++i) {
          const int c = (i * 64 + lane) * 4;
          float4 v = *(float4*)(X + (size_t)row * 1024 + c); const float4 g = *(const float4*)(fg + c);
          v.x *= rs * g.x; v.y *= rs * g.y; v.z *= rs * g.z; v.w *= rs * g.w;
          *(float4*)(X + (size_t)row * 1024 + c) = v;
        }
      }
    }
  PH_END
#undef PH_BEGIN
#undef PH_END
}

#undef X
#undef XB
#undef SSQ
#undef ROPE
#undef DFT
#undef MEMN
#undef MEMK
#undef MEMVT
#undef R
#undef WGU1
#undef WD1
#undef WGU2
#undef WD2
#undef WXQ
#undef WXKV
#undef WXO
#undef WMIX
#undef PQT
#undef HC
#undef YAB
#undef U
#undef Q
#undef KN
#undef VT
#undef O
#undef SQQ
#undef SQKV
#undef QX
#undef OX
constexpr int NPHASES = 2 * 11 + 2 * 16 + 1;

extern "C" void kernel_launch(void* const* d_in, const int* in_sizes, int n_in, void* d_out, int out_size, void* d_ws, size_t ws_size, hipStream_t stream) {
  static int grid_blocks = 0;
  if (grid_blocks == 0) {
    if (n_in != 31 || ws_size < WS_NEED) { fprintf(stderr, "kernel_launch: bad n_in %d or ws_size %zu < %zu\n", n_in, ws_size, (size_t)WS_NEED); grid_blocks = -1; return; }
    int dev = 0, cus = 0, per_cu = 0;
    hipGetDevice(&dev);
    hipDeviceGetAttribute(&cus, hipDeviceAttributeMultiprocessorCount, dev);
    if (hipFuncSetAttribute((const void*)fwd_kernel, hipFuncAttributeMaxDynamicSharedMemorySize, LDS_BYTES) != hipSuccess) { fprintf(stderr, "hipFuncSetAttribute failed\n"); grid_blocks = -1; return; }
    hipOccupancyMaxActiveBlocksPerMultiprocessor(&per_cu, (const void*)fwd_kernel, NTHR, LDS_BYTES);
    if (per_cu < 1) per_cu = 1;
    if (per_cu > 2) per_cu = 2;
    grid_blocks = cus * per_cu;
    fprintf(stderr, "kernel_launch: cus %d per_cu %d grid %d\n", cus, per_cu, grid_blocks);
  }
  if (grid_blocks < 0) return;
  Params p{};
  for (int i = 0; i < 31; ++i) p.in[i] = (const float*)d_in[i];
  p.out = (float*)d_out; p.ws = (unsigned char*)d_ws;
#if MULTI_LAUNCH
  for (int ph = 0; ph < NPHASES; ++ph) {
    p.pb = ph; p.pe = ph + 1;
    hipLaunchKernelGGL(fwd_kernel, dim3(grid_blocks), dim3(NTHR), LDS_BYTES, stream, p);
  }
#else
  p.pb = 0; p.pe = NPHASES;
  void* args[] = {&p};
  hipError_t e = hipLaunchCooperativeKernel((const void*)fwd_kernel, dim3(grid_blocks), dim3(NTHR), args, LDS_BYTES, stream);
  if (e != hipSuccess) fprintf(stderr, "cooperative launch failed: %s (grid %d)\n", hipGetErrorString(e), grid_blocks);
#endif
}
```

```cpp
#include <hip/hip_runtime.h>
#include <hip/hip_cooperative_groups.h>
#include <cstdio>
#include <cstdint>
#include <utility>
namespace cg = cooperative_groups;

#ifndef MULTI_LAUNCH
#define MULTI_LAUNCH 0
#endif

#define DI __device__ __forceinline__
#define PG8_LAS __attribute__((address_space(3)))
#define GAS __attribute__((address_space(1)))
typedef unsigned short bf16_t;
typedef short bf16x8 __attribute__((ext_vector_type(8)));
typedef float f32x4 __attribute__((ext_vector_type(4)));
typedef float f32x16 __attribute__((ext_vector_type(16)));
typedef unsigned u32x4 __attribute__((ext_vector_type(4)));
typedef unsigned u32x2 __attribute__((ext_vector_type(2)));
#define MFMA32(a, b, c) __builtin_amdgcn_mfma_f32_32x32x16_bf16((a), (b), (c), 0, 0, 0)

constexpr int T = 49152, FF = 2816, SEQ = 2048, NSEQ = 24, MEMT = 6144;
constexpr int PT = 16384;
constexpr float EPS = 1e-6f;
constexpr int NTHR = 512, NWV = 8;
constexpr int LDS_STAGE = 131072;
constexpr int RS_OFF = LDS_STAGE + 16;
constexpr int RSC_OFF = RS_OFF + 16384;
constexpr int LDS_BYTES = RSC_OFF + 1024;

constexpr size_t SZ_WGU = (size_t)5632 * 1024 * 2, SZ_WD = (size_t)1024 * 2816 * 2;
constexpr size_t OFF_WGU1 = 0, OFF_WD1 = OFF_WGU1 + SZ_WGU, OFF_WGU2 = OFF_WD1 + SZ_WD, OFF_WD2 = OFF_WGU2 + SZ_WGU;
constexpr size_t OFF_WXQ = OFF_WD2 + SZ_WD, OFF_WXKV = OFF_WXQ + 2097152, OFF_WXO = OFF_WXKV + 4194304;
constexpr size_t OFF_WMIX = OFF_WXO + 2097152;
constexpr size_t WM_ABIN = 0, WM_ABOUT = 4194304;
constexpr size_t WM_MLAIN = 0, WM_QB = 2097152, WM_KN = 3670016, WM_V = 4194304, WM_MLAOUT = 4718592;
constexpr size_t OFF_DFT = OFF_WMIX + 6815744;
constexpr size_t OFF_ROPE = OFF_DFT + 16777216;
constexpr size_t OFF_SSQ = OFF_ROPE + 524288;
constexpr size_t SLOT = (size_t)T * 16;
constexpr size_t OFF_MEMN = OFF_SSQ + 8 * SLOT * 4;
constexpr size_t OFF_MEMK = OFF_MEMN + 12582912, OFF_MEMVT = OFF_MEMK + 12582912;
constexpr size_t OFF_XB = OFF_MEMVT + 12582912;
constexpr size_t OFF_R = OFF_XB + (size_t)T * 1024 * 2;
constexpr size_t OFF_BAR = OFF_R + (size_t)T * 2816 * 2;
constexpr size_t WS_NEED = OFF_BAR + 16384;
constexpr size_t R_PQT = 0, R_HCONV = 100663296, R_YAB = 150994944;
constexpr size_t R_U = 0, R_Q = 88080384, R_KN = 138412032, R_VT = 171966464, R_O = 205520896;
constexpr size_t R_QX = 0, R_OX = 100663296;

struct Params { const float* in[31]; float* out; unsigned char* ws; int pb, pe; };

DI unsigned short f2bf(float x) { unsigned u = __float_as_uint(x); u += 0x7fffu + ((u >> 16) & 1u); return (unsigned short)(u >> 16); }
typedef __bf16 bf16x2_t __attribute__((ext_vector_type(2)));
typedef float f32x2_t __attribute__((ext_vector_type(2)));
DI unsigned pack2(float a, float b) { f32x2_t v = {a, b}; bf16x2_t r = __builtin_convertvector(v, bf16x2_t); return __builtin_bit_cast(unsigned, r); }
DI int lane_asm_() { int t; asm volatile("v_mbcnt_lo_u32_b32 %0, -1, 0\n\tv_mbcnt_hi_u32_b32 %0, -1, %0" : "=v"(t)); return t; }
DI int otid_(int wv) { return (wv << 6) | lane_asm_(); }
#define otid() otid_(wv__)
DI float xsum32(float v) { auto r = __builtin_amdgcn_permlane32_swap(__float_as_uint(v), __float_as_uint(v), false, false); return __uint_as_float(r[0]) + __uint_as_float(r[1]); }
DI float xmax32(float v) { auto r = __builtin_amdgcn_permlane32_swap(__float_as_uint(v), __float_as_uint(v), false, false); return fmaxf(__uint_as_float(r[0]), __uint_as_float(r[1])); }
DI float xsum16(float v) { auto r = __builtin_amdgcn_permlane16_swap(__float_as_uint(v), __float_as_uint(v), false, false); return __uint_as_float(r[0]) + __uint_as_float(r[1]); }
DI float shx(float v, int m) { const int l = lane_asm_(); return __int_as_float(__builtin_amdgcn_ds_bpermute((l ^ m) << 2, __float_as_int(v))); }
DI bool is_t0_(int wv) { return wv == 0 && lane_asm_() == 0; }
#define is_t0() is_t0_(wv__)
DI unsigned char* opq(unsigned char* p) { asm volatile("" : "+s"(p)); return p; }
DI float rstd16(const float* ssq, size_t row, float invd) {
  const float4 a = *(const float4*)(ssq + row * 16), b = *(const float4*)(ssq + row * 16 + 4), c = *(const float4*)(ssq + row * 16 + 8), d = *(const float4*)(ssq + row * 16 + 12);
  const float sm = (((a.x + a.y) + (a.z + a.w)) + ((b.x + b.y) + (b.z + b.w))) + (((c.x + c.y) + (c.z + c.w)) + ((d.x + d.y) + (d.z + d.w)));
  return rsqrtf(sm * invd + EPS);
}
DI int crow(int i, int h) { return (i & 3) + 8 * (i >> 2) + 4 * h; }
DI float sigmoidf_(float x) { return __builtin_amdgcn_rcpf(1.f + __builtin_amdgcn_exp2f(-1.4426950408889634f * x)); }
DI u32x4 pk8v(const f32x4& a, const f32x4& b) { u32x4 w = {pack2(a[0], a[1]), pack2(a[2], a[3]), pack2(b[0], b[1]), pack2(b[2], b[3])}; return w; }
DI u32x4 pk8(const float* v) { u32x4 pk = {pack2(v[0], v[1]), pack2(v[2], v[3]), pack2(v[4], v[5]), pack2(v[6], v[7])}; return pk; }
DI void rope8(float* v, const float2* rope, int pos, int i0) {
#pragma unroll
  for (int j = 0; j < 4; ++j) { float2 cs = rope[pos * 32 + i0 + j]; float x1 = v[2 * j], x2 = v[2 * j + 1]; v[2 * j] = x1 * cs.x - x2 * cs.y; v[2 * j + 1] = x1 * cs.y + x2 * cs.x; }
}

namespace pg8 {
constexpr int BM = 256, BK = 64, HALF = 128, HTB = HALF * BK * 2, STAGE_BYTES = 8 * HTB, NXCD = 8, WGM = 8;
__host__ __device__ __forceinline__ int lds_byte(int r, int c) { const int st = (r >> 4) * 2 + (c >> 5), rr = r & 15, cc = c & 31, ob = rr * 64 + cc * 2; return st * 1024 + (ob ^ (((ob >> 9) & 1) << 5)); }
__host__ __device__ __forceinline__ void stage_rc(int b, int& R, int& C) { const int st = b / 1024, sb = b % 1024, swz = sb ^ (((sb >> 9) & 1) << 5); R = (st >> 1) * 16 + swz / 64; C = (st & 1) * 32 + (swz % 64) / 2; }
__host__ __device__ __forceinline__ int perm32(int rho) { const int n = rho >> 4, i = rho & 15; return 8 * (i >> 2) + 4 * n + (i & 3); }
struct Unit { int pm, pn; };
struct Gemm { const bf16_t* A; const bf16_t* Bt; int M, N, K, lda, ldb; };
struct StaticOrder {
    int nM, nN, nwg, G, c;
    __host__ __device__ void init(int M, int N, int G_, int c_) { nM = M / BM; nN = N / BM; nwg = nM * nN; G = G_; c = c_; }
    __host__ __device__ bool next(int i, Unit& u) const {
        const long L = (long)i * G + c; if (L >= nwg) return false;
        int wgid = (int)L; { const int q = nwg / NXCD, r = nwg % NXCD, xcd = wgid % NXCD, off = wgid / NXCD; wgid = (xcd < r ? xcd * (q + 1) : r * (q + 1) + (xcd - r) * q) + off; }
        const int nig = WGM * nN, gid = wgid / nig, fm = gid * WGM, gsz = (nM - fm) < WGM ? (nM - fm) : WGM;
        u.pm = fm + ((wgid % nig) % gsz); u.pn = (wgid % nig) / gsz; return true;
    }
    __device__ __forceinline__ void a_ready(const Unit&) const {}
    __device__ __forceinline__ void done(const Unit&) const {}
};
template <class Epi, class Sched, bool STAMP = false>
__device__ __forceinline__ void gemm_phase(PG8_LAS unsigned char* lds, const Gemm g, const Sched& S, const Epi& E, unsigned long long* stamps, const int wv__) {
    const int tid = otid(), wid = __builtin_amdgcn_readfirstlane(tid >> 6), lane = tid & 63, wr = wid >> 2, wc = wid & 3, fr = lane & 15, fq = lane >> 4;
    const int K = g.K, nt = K / BK;
    int ts_lo = 0, ts_hi = 0, nts = 0; const unsigned long long rt_entry = STAMP ? (unsigned long long)wall_clock64() : 0ull;
#define PG8_STAMP() do { if (STAMP && wid == 0 && nts < 64) { const unsigned long long _c = (unsigned long long)clock64(); \
        ts_lo = (lane == nts) ? (int)(unsigned)_c : ts_lo; ts_hi = (lane == nts) ? (int)(unsigned)(_c >> 32) : ts_hi; ++nts; } } while (0)
    PG8_STAMP();
    unsigned voffA[2], voffB[2];
#pragma unroll
    for (int i = 0; i < 2; ++i) { int R, C; stage_rc(tid * 16 + i * 8192, R, C); const int Rb = Epi::PERM ? ((R & ~31) + perm32(R & 31)) : R;
        voffA[i] = (unsigned)(R * g.lda + C) * 2u; voffB[i] = (unsigned)(Rb * g.ldb + C) * 2u; }
    const size_t kstep = (size_t)(BK * 2);
    const size_t hstepA = (size_t)HALF * g.lda * 2, hstepB = (size_t)HALF * g.ldb * 2;
    const size_t tstepA = 2 * hstepA, tstepB = 2 * hstepB;
    const unsigned ldsw = (unsigned)wid * 1024u;
    const int aoff = lds_byte(wr * 64 + fr, fq * 8), boff = lds_byte(wc * 32 + fr, fq * 8);
#define PG8_SA(b, h) (((b) * 2 + (h)) * HTB)
#define PG8_SB(b, h) ((4 + (b) * 2 + (h)) * HTB)
#define PG8_STAGE(bufoff, gbase, voff) do { _Pragma("unroll") for (int _i = 0; _i < 2; ++_i) \
        __builtin_amdgcn_global_load_lds((const unsigned*)((const char*)(gbase) + (voff)[_i]), (PG8_LAS unsigned*)(lds + (bufoff) + ldsw + _i * 8192), 16, 0, 0); } while (0)
#define PG8_LDA(dst, b, h) do { _Pragma("unroll") for (int m = 0; m < 4; ++m) _Pragma("unroll") for (int k = 0; k < 2; ++k) dst[m][k] = *(const PG8_LAS bf16x8*)(lds + PG8_SA(b, h) + aoff + m * 2048 + k * 1024); } while (0)
#define PG8_LDB(dst, b, h) do { _Pragma("unroll") for (int n = 0; n < 2; ++n) _Pragma("unroll") for (int k = 0; k < 2; ++k) dst[n][k] = *(const PG8_LAS bf16x8*)(lds + PG8_SB(b, h) + boff + n * 2048 + k * 1024); } while (0)
#define PG8_MMA(ai, bj, At, Bt) do { __builtin_amdgcn_s_setprio(1); _Pragma("unroll") for (int m = 0; m < 4; ++m) _Pragma("unroll") for (int n = 0; n < 2; ++n) _Pragma("unroll") for (int k = 0; k < 2; ++k) \
        acc[ai][bj][m][n] = __builtin_amdgcn_mfma_f32_16x16x32_bf16(Bt[n][k], At[m][k], acc[ai][bj][m][n], 0, 0, 0); __builtin_amdgcn_s_setprio(0); } while (0)
#define PG8_WAIT_V(n) asm volatile("s_waitcnt vmcnt(" #n ")" ::: "memory")
#define PG8_WAIT_L(n) asm volatile("s_waitcnt lgkmcnt(" #n ")" ::: "memory")
#define PG8_BAR __builtin_amdgcn_s_barrier()
#define PG8_SCHED __builtin_amdgcn_sched_barrier(0)
    Unit cur, nxt; int ui = 0;
    if (!S.next(0, cur)) return;
    f32x4 acc[2][2][4][2];
    if constexpr (!Epi::ACC_INIT)
#pragma unroll
    for (int a = 0; a < 2; ++a)
#pragma unroll
        for (int b = 0; b < 2; ++b)
#pragma unroll
            for (int m = 0; m < 4; ++m)
#pragma unroll
                for (int n = 0; n < 2; ++n) acc[a][b][m][n] = (f32x4){0.f, 0.f, 0.f, 0.f};
    bf16x8 At[4][2], B0[2][2], B1[2][2];
    const char* cA = (const char*)g.A + (size_t)cur.pm * tstepA; const char* cB = (const char*)g.Bt + (size_t)cur.pn * tstepB;
    S.a_ready(cur);
    PG8_STAGE(PG8_SB(0, 0), cB, voffB); PG8_STAGE(PG8_SA(0, 0), cA, voffA); PG8_STAGE(PG8_SB(0, 1), cB + hstepB, voffB); PG8_STAGE(PG8_SA(0, 1), cA + hstepA, voffA);
    if (wr == 1) PG8_BAR;
    PG8_WAIT_V(4); PG8_BAR;
    PG8_STAGE(PG8_SB(1, 0), cB + kstep, voffB); PG8_STAGE(PG8_SA(1, 0), cA + kstep, voffA); PG8_STAGE(PG8_SB(1, 1), cB + hstepB + kstep, voffB);
    PG8_WAIT_V(6); PG8_BAR;
    PG8_STAMP();
    for (;;) {
        if constexpr (Epi::RSM != 0) { if (E.e.ssq) {
            const int rr_ = wr * 64 + (wc & 1) * 32 + (wc >> 1) * 128;
            const char* rb_ = (const char*)E.e.ssq + ((size_t)cur.pm * BM + rr_) * 64 + lane * 16;
            __builtin_amdgcn_global_load_lds((const unsigned*)rb_, (PG8_LAS unsigned*)(lds + RS_OFF + rr_ * 64), 16, 0, 0);
            __builtin_amdgcn_global_load_lds((const unsigned*)(rb_ + 1024), (PG8_LAS unsigned*)(lds + RS_OFF + rr_ * 64 + 1024), 16, 0, 0); } }
        if constexpr (Epi::ACC_INIT) E.init(acc, cur, wr, wc, fr, fq);
        const bool has_next = S.next(ui + 1, nxt);
        const char* nA = has_next ? (const char*)g.A + (size_t)nxt.pm * tstepA : cA; const char* nB = has_next ? (const char*)g.Bt + (size_t)nxt.pn * tstepB : cB;
        for (int t = 0; t < nt; t += 2) {
            const bool last = (t == nt - 2);
            const char* a1 = cA + (size_t)(t + 1) * kstep;
            const char* a2 = last ? nA : cA + (size_t)(t + 2) * kstep; const char* b2 = last ? nB : cB + (size_t)(t + 2) * kstep;
            const char* a3 = a2 + kstep; const char* b3 = b2 + kstep;
            if (last && has_next) S.a_ready(nxt);
            PG8_LDB(B0, 0, 0); PG8_SCHED; PG8_LDA(At, 0, 0); PG8_STAGE(PG8_SA(1, 1), a1 + hstepA, voffA);
            PG8_WAIT_L(8); PG8_BAR; PG8_WAIT_L(0); PG8_MMA(0, 0, At, B0); PG8_BAR; PG8_SCHED;
            PG8_LDB(B1, 0, 1); PG8_STAGE(PG8_SB(0, 0), b2, voffB);
            PG8_BAR; PG8_WAIT_L(0); PG8_MMA(0, 1, At, B1); PG8_BAR;
            PG8_LDA(At, 0, 1); PG8_STAGE(PG8_SA(0, 0), a2, voffA);
            PG8_BAR; PG8_WAIT_L(0); PG8_MMA(1, 0, At, B0); PG8_BAR; PG8_SCHED;
            PG8_STAGE(PG8_SB(0, 1), b2 + hstepB, voffB);
            PG8_WAIT_V(6); PG8_BAR; PG8_MMA(1, 1, At, B1); PG8_BAR;
            PG8_LDB(B0, 1, 0); PG8_SCHED; PG8_LDA(At, 1, 0); PG8_STAGE(PG8_SA(0, 1), a2 + hstepA, voffA);
            PG8_WAIT_L(8); PG8_BAR; PG8_WAIT_L(0); PG8_MMA(0, 0, At, B0); PG8_BAR; PG8_SCHED;
            PG8_LDB(B1, 1, 1); PG8_STAGE(PG8_SB(1, 0), b3, voffB);
            PG8_BAR; PG8_WAIT_L(0); PG8_MMA(0, 1, At, B1); PG8_BAR;
            PG8_LDA(At, 1, 1); PG8_STAGE(PG8_SA(1, 0), a3, voffA);
            PG8_BAR; PG8_WAIT_L(0); PG8_MMA(1, 0, At, B0); PG8_BAR; PG8_SCHED;
            PG8_STAGE(PG8_SB(1, 1), b3 + hstepB, voffB);
            PG8_WAIT_V(6); PG8_BAR; PG8_MMA(1, 1, At, B1); PG8_BAR;
        }
        PG8_STAMP();
        if constexpr (Epi::RSM != 0) { if (E.e.ssq) {
            const int t2 = tid & 255;
            if (t2 < 128) {
                const int rl = wr * 64 + (t2 & 63) + (t2 >> 6) * 128;
                const PG8_LAS f32x4* p = (const PG8_LAS f32x4*)(lds + RS_OFF + rl * 64);
                const f32x4 a = p[0], b = p[1], c = p[2], d = p[3];
                const float sm = (((a[0] + a[1]) + (a[2] + a[3])) + ((b[0] + b[1]) + (b[2] + b[3]))) + (((c[0] + c[1]) + (c[2] + c[3])) + ((d[0] + d[1]) + (d[2] + d[3])));
                *(PG8_LAS float*)(lds + RSC_OFF + rl * 4) = rsqrtf(sm * E.e.f1 + EPS);
            }
            PG8_WAIT_L(0); PG8_BAR;
        } }
        if constexpr (!Epi::AFTER_DRAIN) { E(acc, cur, wr, wc, fr, fq); S.done(cur); }
        PG8_STAMP();
        if (!has_next) break;
        if constexpr (!Epi::ACC_INIT)
#pragma unroll
        for (int a = 0; a < 2; ++a)
#pragma unroll
            for (int b = 0; b < 2; ++b)
#pragma unroll
                for (int m = 0; m < 4; ++m)
#pragma unroll
                    for (int n = 0; n < 2; ++n) acc[a][b][m][n] = (f32x4){0.f, 0.f, 0.f, 0.f};
        cur = nxt; cA = nA; cB = nB; ++ui;
    }
    PG8_WAIT_V(0);
    if (wr == 0) PG8_BAR;
    PG8_BAR;
    if constexpr (Epi::AFTER_DRAIN) { E.fused(acc, cur, wr, wc, fr, fq, lds, wid, lane); S.done(cur); }
    PG8_STAMP();
    if (STAMP && wid == 0) { stamps[lane] = lane < nts ? (((unsigned long long)(unsigned)ts_hi << 32) | (unsigned)ts_lo) : 0ull;
        if (lane == 62) stamps[62] = rt_entry; if (lane == 63) stamps[63] = (unsigned long long)wall_clock64(); }
#undef PG8_STAMP
#undef PG8_SA
#undef PG8_SB
#undef PG8_STAGE
#undef PG8_LDA
#undef PG8_LDB
#undef PG8_MMA
#undef PG8_WAIT_V
#undef PG8_WAIT_L
#undef PG8_BAR
#undef PG8_SCHED
}
}

enum { EPI_STORE = 0, EPI_FOUR, EPI_RESID, EPI_SWIGLU, EPI_GLUAB, EPI_PQT, EPI_VT, EPI_MEMVT, EPI_MLAIN, EPI_Q };
struct EpiArgs { void* p0; void* p1; void* p2; const float* ssq; const float2* rope; float f0; float f1; int i0; int i1; };

template <int EPI> struct EpiF {
  static constexpr bool PERM = true, AFTER_DRAIN = false;
  static constexpr int RSM = (EPI == EPI_STORE || EPI == EPI_SWIGLU || EPI == EPI_GLUAB || EPI == EPI_MLAIN || EPI == EPI_Q) ? 1 : 0;
  static constexpr bool ACC_INIT = (EPI == EPI_RESID);
  EpiArgs e; const PG8_LAS float* rsc;
  DI void init(f32x4 (&acc)[2][2][4][2], const pg8::Unit& u, int wr, int wc, int fr, int fq) const {
    if constexpr (EPI == EPI_RESID) {
      const GAS bf16_t* xb = (const GAS bf16_t*)e.p1; const float ia = 1.f / e.f0;
      const int rbase = u.pm * 256 + wr * 64 + fr, cbase = u.pn * 256 + wc * 32 + fq * 8;
      u32x4 xo[2][4][2];
#pragma unroll
      for (int ai = 0; ai < 2; ++ai)
#pragma unroll
        for (int m = 0; m < 4; ++m)
#pragma unroll
          for (int bj = 0; bj < 2; ++bj) xo[ai][m][bj] = *(const GAS u32x4*)(xb + (size_t)(rbase + ai * 128 + m * 16) * 1024 + cbase + bj * 128);
#pragma unroll
      for (int ai = 0; ai < 2; ++ai)
#pragma unroll
        for (int m = 0; m < 4; ++m)
#pragma unroll
          for (int bj = 0; bj < 2; ++bj)
#pragma unroll
            for (int j = 0; j < 4; ++j) {
              acc[ai][bj][m][j >> 1][(j & 1) * 2] = __uint_as_float(xo[ai][m][bj][j] << 16) * ia;
              acc[ai][bj][m][j >> 1][(j & 1) * 2 + 1] = __uint_as_float(xo[ai][m][bj][j] & 0xffff0000u) * ia;
            }
    }
  }
  DI void operator()(const f32x4 (&acc)[2][2][4][2], const pg8::Unit& u, int wr, int wc, int fr, int fq) const {
    const int rbase = u.pm * 256 + wr * 64 + fr;
    const int rloc = wr * 64 + fr;
    const int cbase = u.pn * 256 + wc * 32 + fq * 8;
    if constexpr (EPI == EPI_STORE) {
      GAS bf16_t* out = (GAS bf16_t*)e.p0; const int ldo = e.i0;
#pragma unroll
      for (int ai = 0; ai < 2; ++ai)
#pragma unroll
        for (int m = 0; m < 4; ++m) {
          const size_t row = (size_t)(rbase + ai * 128 + m * 16);
          float rs = e.f0; if (e.ssq) rs *= rsc[rloc + ai * 128 + m * 16];
#pragma unroll
          for (int bj = 0; bj < 2; ++bj) *(GAS u32x4*)(out + row * ldo + cbase + bj * 128) = pk8v(acc[ai][bj][m][0] * rs, acc[ai][bj][m][1] * rs);
        }
    } else if constexpr (EPI == EPI_FOUR) {
      GAS bf16_t* out = (GAS bf16_t*)e.p0;
#pragma unroll
      for (int ai = 0; ai < 2; ++ai)
#pragma unroll
        for (int m = 0; m < 4; ++m) {
          const int s = rbase + ai * 128 + m * 16;
#pragma unroll
          for (int bj = 0; bj < 2; ++bj) { const int col = cbase + bj * 128; const int b = col >> 9, ch = col & 511;
            *(GAS u32x4*)(out + ((size_t)b * 2048 + s) * 1024 + ch) = pk8v(acc[ai][bj][m][0] * e.f0, acc[ai][bj][m][1] * e.f0); }
        }
    } else if constexpr (EPI == EPI_RESID) {
      GAS bf16_t* xb = (GAS bf16_t*)e.p1; GAS float* ssqn = (GAS float*)e.p2;
#pragma unroll
      for (int ai = 0; ai < 2; ++ai)
#pragma unroll
        for (int m = 0; m < 4; ++m) {
          const size_t row = (size_t)(rbase + ai * 128 + m * 16);
          float ss = 0.f;
#pragma unroll
          for (int bj = 0; bj < 2; ++bj) {
            u32x4 xn;
#pragma unroll
            for (int j = 0; j < 4; ++j) {
              const unsigned pk = pack2(acc[ai][bj][m][j >> 1][(j & 1) * 2] * e.f0, acc[ai][bj][m][j >> 1][(j & 1) * 2 + 1] * e.f0);
              xn[j] = pk;
              const float r0 = __uint_as_float(pk << 16), r1 = __uint_as_float(pk & 0xffff0000u);
              ss += r0 * r0 + r1 * r1;
            }
            *(GAS u32x4*)(xb + row * 1024 + cbase + bj * 128) = xn;
          }
          ss = xsum16(ss); ss = xsum32(ss);
          if (fq == 0) ssqn[row * 16 + u.pn * 4 + wc] = ss;
        }
    } else if constexpr (EPI == EPI_SWIGLU || EPI == EPI_GLUAB) {
      GAS bf16_t* out = (GAS bf16_t*)e.p0; const int ldo = e.i0;
#pragma unroll
      for (int ai = 0; ai < 2; ++ai)
#pragma unroll
        for (int m = 0; m < 4; ++m) {
          const size_t row = (size_t)(rbase + ai * 128 + m * 16);
          const float rs = rsc[rloc + ai * 128 + m * 16];
          float v[8];
#pragma unroll
          for (int n = 0; n < 2; ++n)
#pragma unroll
            for (int j = 0; j < 4; ++j) {
              const float a = acc[ai][0][m][n][j] * rs, b = acc[ai][1][m][n][j] * rs;
              v[n * 4 + j] = (EPI == EPI_SWIGLU) ? (a * sigmoidf_(a) * b) : (a * sigmoidf_(b));
            }
          *(GAS u32x4*)(out + row * ldo + u.pn * 128 + wc * 32 + fq * 8) = pk8(v);
        }
    } else if constexpr (EPI == EPI_PQT || EPI == EPI_VT || EPI == EPI_MEMVT) {
      GAS bf16_t* out = (GAS bf16_t*)e.p0;
#pragma unroll
      for (int bj = 0; bj < 2; ++bj) {
        const int tok0 = cbase + bj * 128;
        float rs[8];
#pragma unroll
        for (int j = 0; j < 8; ++j) rs[j] = (EPI == EPI_MEMVT) ? 1.f : rstd16(e.ssq, (size_t)(tok0 + j), e.f1);
#pragma unroll
        for (int ai = 0; ai < 2; ++ai)
#pragma unroll
          for (int m = 0; m < 4; ++m) {
            const int n = rbase + ai * 128 + m * 16;
            size_t dst;
            if constexpr (EPI == EPI_PQT) { const int b = tok0 >> 11, pos = tok0 & 2047; dst = ((size_t)b * 512 + (n & 511)) * 4096 + (n >> 9) * 2048 + pos; }
            else if constexpr (EPI == EPI_VT) { const int b = tok0 >> 11, pos = tok0 & 2047; dst = ((size_t)b * 1024 + n) * 2048 + pos; }
            else { const int b = tok0 >> 8, mm = tok0 & 255; dst = ((size_t)b * 1024 + n) * 256 + mm; }
            float v[8];
#pragma unroll
            for (int nn = 0; nn < 2; ++nn)
#pragma unroll
              for (int j = 0; j < 4; ++j) v[nn * 4 + j] = acc[ai][bj][m][nn][j] * rs[nn * 4 + j];
            *(GAS u32x4*)(out + dst) = pk8(v);
          }
        __builtin_amdgcn_sched_barrier(0);
      }
    } else if constexpr (EPI == EPI_MLAIN) {
      GAS bf16_t* uo = (GAS bf16_t*)e.p0; GAS float* ssq_q = (GAS float*)e.p1; GAS float* ssq_kv = (GAS float*)e.p2;
#pragma unroll
      for (int ai = 0; ai < 2; ++ai)
#pragma unroll
        for (int m = 0; m < 4; ++m) {
          const size_t row = (size_t)(rbase + ai * 128 + m * 16);
          const float rs = rsc[rloc + ai * 128 + m * 16];
          float ss = 0.f;
#pragma unroll
          for (int bj = 0; bj < 2; ++bj) {
            const int col = cbase + bj * 128;
            float v[8];
#pragma unroll
            for (int nn = 0; nn < 2; ++nn)
#pragma unroll
              for (int j = 0; j < 4; ++j) { v[nn * 4 + j] = acc[ai][bj][m][nn][j] * rs; ss += v[nn * 4 + j] * v[nn * 4 + j]; }
            if (u.pn == 3) { if (col < 832) rope8(v, e.rope, (int)(row & 2047), (col - 768) >> 1); }
            if (col < 832) *(GAS u32x4*)(uo + row * 896 + col) = pk8(v);
          }
          if (u.pn < 3) {
            ss = xsum16(ss); ss = xsum32(ss);
            if (fq == 0) { if (u.pn < 2) ssq_q[row * 16 + u.pn * 4 + wc] = ss; else ssq_kv[row * 16 + wc] = ss; }
          }
        }
    } else if constexpr (EPI == EPI_Q) {
      GAS bf16_t* q = (GAS bf16_t*)e.p0;
#pragma unroll
      for (int ai = 0; ai < 2; ++ai)
#pragma unroll
        for (int m = 0; m < 4; ++m) {
          const size_t row = (size_t)(rbase + ai * 128 + m * 16);
          const float rs = rsc[rloc + ai * 128 + m * 16];
#pragma unroll
          for (int bj = 0; bj < 2; ++bj) {
            const int col = cbase + bj * 128; const int cc = col % 192;
            float v[8];
#pragma unroll
            for (int nn = 0; nn < 2; ++nn)
#pragma unroll
              for (int j = 0; j < 4; ++j) v[nn * 4 + j] = acc[ai][bj][m][nn][j] * rs;
            if (cc >= 128) rope8(v, e.rope, (int)(row & 2047), (cc - 128) >> 1);
#pragma unroll
            for (int j = 0; j < 8; ++j) v[j] *= e.f0;
            *(GAS u32x4*)(q + row * 1536 + col) = pk8(v);
          }
        }
    }
  }
};

template <int EPI>
DI void gemm_job_(const bf16_t* A, int lda, const bf16_t* Bt, int ldb, int M, int N, int K, const EpiArgs& ea, unsigned char* smem, int shift, const int wv__) {
  asm volatile("" : "+s"(K));
  pg8::Gemm g{A, Bt, M, N, K, lda, ldb};
  pg8::StaticOrder S; const int G = gridDim.x; const int cid = __builtin_amdgcn_readfirstlane((int)((volatile PG8_LAS unsigned*)((PG8_LAS unsigned char*)smem + LDS_STAGE))[2]);
  if (shift == -128 && G == 256) S.init(M, N, 128, cid >= 128 ? cid - 128 : (1 << 28));
  else S.init(M, N, G, (int)((cid + G - ((shift < 0 ? 0 : shift) % G)) % G));
  EpiF<EPI> E{ea, (const PG8_LAS float*)((PG8_LAS unsigned char*)smem + RSC_OFF)};
  pg8::gemm_phase<EpiF<EPI>, pg8::StaticOrder, false>((PG8_LAS unsigned char*)smem, g, S, E, nullptr, wv__);
  __syncthreads();
}

template <int DQK, int K0C, int DVC>
DI void attn_unit(const bf16_t* __restrict__ q, long ldq, const bf16_t* __restrict__ k0, long ldk0, const bf16_t* __restrict__ k1, long ldk1,
                  const bf16_t* __restrict__ vt, long ldvt, int nkeys, bf16_t* __restrict__ o, long ldo, unsigned char* smem, const int wv__) {
  constexpr int LDK = DQK + 8, CPR = DQK / 8, NKS = DQK / 16, ND = DVC / 32;
  constexpr int KIT = (64 * CPR) / NTHR, VIT = (DVC * 8) / NTHR;
  constexpr int KBYTES = 64 * LDK * 2, VBYTES = DVC * 72 * 2, BUFB = KBYTES + VBYTES;
  const int tid = otid(), lane = tid & 63, w = tid >> 6, r = lane & 31, h = lane >> 5;
  const GAS bf16_t* k0g = (const GAS bf16_t*)k0; const GAS bf16_t* k1g = (const GAS bf16_t*)k1; const GAS bf16_t* vtg = (const GAS bf16_t*)vt;
  bf16x8 bq[NKS];
  {
    const GAS bf16_t* qp = (const GAS bf16_t*)q + (long)(w * 32 + r) * ldq + h * 8;
#pragma unroll
    for (int ks = 0; ks < NKS; ++ks) bq[ks] = *(const GAS bf16x8*)(qp + ks * 16);
  }
  f32x16 oacc[ND];
#pragma unroll
  for (int d = 0; d < ND; ++d)
#pragma unroll
    for (int i = 0; i < 16; ++i) oacc[d][i] = 0.f;
  float m_run = -1e30f, l_run = 0.f;
  u32x4 rk[KIT], rv[VIT];
#define ATT_GLOAD(key0) do { \
    _Pragma("unroll") for (int it = 0; it < KIT; ++it) { \
      const int c_ = tid + NTHR * it; const int krow_ = c_ / CPR; const int kcol_ = (c_ - krow_ * CPR) * 8; \
      const GAS bf16_t* src = (kcol_ < K0C) ? (k0g + (long)((key0) + krow_) * ldk0 + kcol_) : (k1g + (long)((key0) + krow_) * ldk1 + (kcol_ - K0C)); \
      rk[it] = *(const GAS u32x4*)src; } \
    _Pragma("unroll") for (int it = 0; it < VIT; ++it) { const int c = tid + NTHR * it; rv[it] = *(const GAS u32x4*)(vtg + (long)(c >> 3) * ldvt + (key0) + (c & 7) * 8); } } while (0)
#define ATT_LSTORE(buf) do { \
    bf16_t* dK = (bf16_t*)(smem + (buf) * BUFB); bf16_t* dV = (bf16_t*)(smem + (buf) * BUFB + KBYTES); \
    _Pragma("unroll") for (int it = 0; it < KIT; ++it) { const int c_ = tid + NTHR * it; const int krow_ = c_ / CPR; const int kcol_ = (c_ - krow_ * CPR) * 8; *(u32x4*)(dK + krow_ * LDK + kcol_) = rk[it]; } \
    _Pragma("unroll") for (int it = 0; it < VIT; ++it) { const int c = tid + NTHR * it; *(u32x4*)(dV + (c >> 3) * 72 + (c & 7) * 8) = rv[it]; } } while (0)
  __syncthreads();
  ATT_GLOAD(0);
  ATT_LSTORE(0);
  __syncthreads();
  const int ntiles = nkeys >> 6;
  for (int kt = 0; kt < ntiles; ++kt) {
    const int cur = kt & 1; const bool more = (kt + 1 < ntiles);
    if (more) ATT_GLOAD((kt + 1) * 64);
    const bf16_t* sK = (const bf16_t*)(smem + cur * BUFB); const bf16_t* sV = (const bf16_t*)(smem + cur * BUFB + KBYTES);
    f32x16 st[2];
#pragma unroll
    for (int i = 0; i < 16; ++i) { st[0][i] = 0.f; st[1][i] = 0.f; }
    const PG8_LAS bf16_t* kp = (const PG8_LAS bf16_t*)sK + r * LDK + h * 8;
    {
      bf16x8 c0 = *(const PG8_LAS bf16x8*)(kp), c1 = *(const PG8_LAS bf16x8*)(kp + 32 * LDK);
      __builtin_amdgcn_sched_barrier(0);
#pragma unroll
      for (int ks = 0; ks < NKS; ++ks) {
        bf16x8 e0 = c0, e1 = c1;
        if (ks + 1 < NKS) { e0 = *(const PG8_LAS bf16x8*)(kp + (ks + 1) * 16); e1 = *(const PG8_LAS bf16x8*)(kp + 32 * LDK + (ks + 1) * 16); }
        st[0] = MFMA32(c0, bq[ks], st[0]); st[1] = MFMA32(c1, bq[ks], st[1]);
        __builtin_amdgcn_sched_group_barrier(0x100, 2, 0); __builtin_amdgcn_sched_group_barrier(0x008, 2, 0);
        __builtin_amdgcn_sched_barrier(0);
        c0 = e0; c1 = e1;
      }
    }
    __builtin_amdgcn_sched_barrier(0);
    float mx = st[0][0];
#pragma unroll
    for (int i = 0; i < 16; ++i) { mx = fmaxf(mx, st[0][i]); mx = fmaxf(mx, st[1][i]); }
    mx = xmax32(mx);
    const float m_new = fmaxf(m_run, mx);
    const float alpha = __builtin_amdgcn_exp2f(m_run - m_new);
    m_run = m_new;
    float ls = 0.f;
#pragma unroll
    for (int i = 0; i < 16; ++i) { st[0][i] = __builtin_amdgcn_exp2f(st[0][i] - m_new); st[1][i] = __builtin_amdgcn_exp2f(st[1][i] - m_new); ls += st[0][i] + st[1][i]; }
    l_run = l_run * alpha + ls;
    if (__builtin_amdgcn_ballot_w64(alpha != 1.f) != 0ull) {
#pragma unroll
      for (int d = 0; d < ND; ++d)
#pragma unroll
        for (int i = 0; i < 16; ++i) oacc[d][i] *= alpha;
    }
    __builtin_amdgcn_sched_barrier(0);
    {
      bf16x8 pb[4];
#pragma unroll
      for (int s = 0; s < 4; ++s) {
        const int mi = s >> 1, sub = s & 1;
        u32x4 pp = {pack2(st[mi][8 * sub + 0], st[mi][8 * sub + 1]), pack2(st[mi][8 * sub + 2], st[mi][8 * sub + 3]),
                    pack2(st[mi][8 * sub + 4], st[mi][8 * sub + 5]), pack2(st[mi][8 * sub + 6], st[mi][8 * sub + 7])};
        pb[s] = __builtin_bit_cast(bf16x8, pp);
      }
      const PG8_LAS bf16_t* vb = (const PG8_LAS bf16_t*)sV + r * 72 + 4 * h;
      u32x2 lo = *(const PG8_LAS u32x2*)vb, hi = *(const PG8_LAS u32x2*)(vb + 8);
      __builtin_amdgcn_sched_barrier(0);
#pragma unroll
      for (int i_ = 0; i_ < 4 * ND; ++i_) {
        const int s = i_ / ND, d = i_ % ND;
        u32x2 nlo = lo, nhi = hi;
        if (i_ + 1 < 4 * ND) { const int s2 = (i_ + 1) / ND, d2 = (i_ + 1) % ND; const PG8_LAS bf16_t* vp = vb + d2 * 32 * 72 + s2 * 16; nlo = *(const PG8_LAS u32x2*)vp; nhi = *(const PG8_LAS u32x2*)(vp + 8); }
        u32x4 av = {lo[0], lo[1], hi[0], hi[1]};
        oacc[d] = MFMA32(__builtin_bit_cast(bf16x8, av), pb[s], oacc[d]);
        __builtin_amdgcn_sched_group_barrier(0x100, 2, 0); __builtin_amdgcn_sched_group_barrier(0x008, 1, 0);
        __builtin_amdgcn_sched_barrier(0);
        lo = nlo; hi = nhi;
      }
    }
    __builtin_amdgcn_sched_barrier(0);
    if (more) ATT_LSTORE(cur ^ 1);
    __syncthreads();
  }
#undef ATT_GLOAD
#undef ATT_LSTORE
  const float l_tot = xsum32(l_run);
  const float inv = 1.f / l_tot;
  const int tid2 = otid();
  GAS bf16_t* op = (GAS bf16_t*)o + (long)((tid2 >> 6) * 32 + (tid2 & 31)) * ldo;
#pragma unroll
  for (int d = 0; d < ND; ++d)
#pragma unroll
    for (int g = 0; g < 4; ++g) {
      u32x2 pk = {pack2(oacc[d][4 * g] * inv, oacc[d][4 * g + 1] * inv), pack2(oacc[d][4 * g + 2] * inv, oacc[d][4 * g + 3] * inv)};
      *(GAS u32x2*)(op + d * 32 + 8 * g + 4 * h) = pk;
    }
}

template <int RR>
DI void conv_step(float2 (&v)[8], const float2 (&wv)[31], const unsigned* sp) {
  const unsigned xx = sp[RR * 256];
  const float x0 = __uint_as_float(xx << 16), x1 = __uint_as_float(xx & 0xffff0000u);
#pragma unroll
  for (int t = 0; t < 8; ++t) {
    const int j = RR - t;
    if (j >= 0 && j < 31) { v[t].x += wv[j].x * x0; v[t].y += wv[j].y * x1; }
  }
  if constexpr ((RR & 3) == 3) __builtin_amdgcn_sched_barrier(0);
}
template <int... RR>
DI void conv_all(float2 (&v)[8], const float2 (&wv)[31], const unsigned* sp, std::integer_sequence<int, RR...>) { (conv_step<RR>(v, wv, sp), ...); }

DI void conv_unit(const bf16_t* __restrict__ hc, const float* __restrict__ cw, const float* __restrict__ cb, const float* __restrict__ lg, const float* __restrict__ lb,
                  bf16_t* __restrict__ yab, int b, int jt, unsigned char* smem, const int wv__) {
  bf16_t* sH = (bf16_t*)smem;
  float* sRed = (float*)(smem + 62 * 512 * 2);
  const int tid = otid(), lane = tid & 63, w = (tid >> 6) & 3, ch2 = tid & 255, hb = tid >> 8;
  __syncthreads();
  for (int c = tid; c < 62 * 64; c += NTHR) {
    const int row = c >> 6, kc = c & 63; const int pos = jt * 32 - 15 + row;
    u32x4 v = {0u, 0u, 0u, 0u};
    if (pos >= 0 && pos < SEQ) v = *(const u32x4*)(hc + ((size_t)b * SEQ + pos) * 512 + kc * 8);
    *(u32x4*)(sH + row * 512 + kc * 8) = v;
  }
  float2 wv[31];
#pragma unroll
  for (int j = 0; j < 31; ++j) wv[j] = *(const float2*)(cw + j * 512 + 2 * ch2);
  const float2 bias = *(const float2*)(cb + 2 * ch2);
  const float2 g2 = *(const float2*)(lg + 2 * ch2), b2 = *(const float2*)(lb + 2 * ch2);
  __syncthreads();
  const unsigned* sH32 = (const unsigned*)sH;
#pragma unroll 1
  for (int tgi = 0; tgi < 2; ++tgi) {
    const int tg = hb * 2 + tgi;
    float2 v[8];
#pragma unroll
    for (int t = 0; t < 8; ++t) v[t] = bias;
    conv_all(v, wv, sH32 + tg * 8 * 256 + ch2, std::make_integer_sequence<int, 38>{});
#pragma unroll
    for (int t = 0; t < 8; ++t) {
      float s1 = v[t].x + v[t].y, s2 = v[t].x * v[t].x + v[t].y * v[t].y;
#pragma unroll
      for (int m = 1; m < 64; m <<= 1) { s1 += shx(s1, m); s2 += shx(s2, m); }
      if (lane == 0) { sRed[((tg * 4 + w) * 8 + t) * 2] = s1; sRed[((tg * 4 + w) * 8 + t) * 2 + 1] = s2; }
    }
    __syncthreads();
#pragma unroll
    for (int t = 0; t < 8; ++t) {
      float s1 = 0.f, s2 = 0.f;
#pragma unroll
      for (int ww = 0; ww < 4; ++ww) { s1 += sRed[((tg * 4 + ww) * 8 + t) * 2]; s2 += sRed[((tg * 4 + ww) * 8 + t) * 2 + 1]; }
      const float mean = s1 * (1.f / 512.f); const float var = fmaxf(s2 * (1.f / 512.f) - mean * mean, 0.f);
      const float rs = rsqrtf(var + EPS);
      float y0 = (v[t].x - mean) * rs * g2.x + b2.x, y1 = (v[t].y - mean) * rs * g2.y + b2.y;
      y0 = y0 * sigmoidf_(y0); y1 = y1 * sigmoidf_(y1);
      *(unsigned*)(yab + ((size_t)b * SEQ + jt * 32 + tg * 8 + t) * 1024 + 512 + 2 * ch2) = pack2(y0, y1);
    }
  }
}

enum { WM_ID = 0, WM_GLU, WM_MLAINP, WM_QBP, WM_KVS };
DI void wconv_job(const float* __restrict__ src0, const float* __restrict__ src1, int lds_, const float* __restrict__ g, bf16_t* __restrict__ dst, int Nd, int K, int mode, int moff,
                  unsigned char* smem, int shift, const int wv__) {
  float* sT = (float*)smem;
  const int G = gridDim.x;
  const int kt_n = K >> 7; const int total = (Nd >> 6) * kt_n;
  for (int u = (int)((blockIdx.x + G - (shift % G)) % G); u < total; u += G) {
    const int tid = otid();
    const int tnn = u / kt_n, tk = u - tnn * kt_n;
    const int n = tnn * 64 + (tid & 63);
    const float* sp = src0; int sc = n;
    if (mode == WM_GLU) { const int tl = n >> 8, i = n & 255; if (i < 128) sc = tl * 128 + i; else { sc = tl * 128 + i - 128; sp = src1; } }
    else if (mode == WM_MLAINP) { if (n >= 832) sc = -1; else if (n >= 768) { const int p = n - 768; sc = 768 + (p >> 1) + (p & 1) * 32; } }
    else if (mode == WM_QBP) { const int hh = n / 192, c = n - hh * 192; if (c >= 128) { const int p = c - 128; sc = hh * 192 + 128 + (p >> 1) + (p & 1) * 32; } }
    else if (mode == WM_KVS) { sc = (n >> 7) * 256 + moff + (n & 127); }
    float v[16];
    const int k0 = tk * 128 + (tid >> 6);
#pragma unroll
    for (int i = 0; i < 16; ++i) v[i] = (sc >= 0) ? sp[(size_t)(k0 + 8 * i) * lds_ + sc] : 0.f;
    if (g) {
#pragma unroll
      for (int i = 0; i < 16; ++i) v[i] *= g[k0 + 8 * i];
    }
    __syncthreads();
#pragma unroll
    for (int i = 0; i < 16; ++i) sT[((tid >> 6) + 8 * i) * 65 + (tid & 63)] = v[i];
    __syncthreads();
    const int nl = tid >> 3, kc = (tid & 7) * 16;
    float w[16];
#pragma unroll
    for (int j = 0; j < 16; ++j) w[j] = sT[(kc + j) * 65 + nl];
    bf16_t* dp = dst + (size_t)(tnn * 64 + nl) * K + tk * 128 + kc;
    *(u32x4*)dp = pk8(w); *(u32x4*)(dp + 8) = pk8(w + 8);
  }
}
DI void wpq_job(const float* __restrict__ win, const float* __restrict__ gm, bf16_t* __restrict__ dst, unsigned char* smem, const int wv__) {
  float* sW = (float*)smem;
  float* tab = sW + 64 * 129;
  const int G = gridDim.x;
  for (int u = blockIdx.x; u < 256; u += G) {
    const int tid = otid();
    const int kt = u >> 4, gq = (u >> 2) & 3, jq = u & 3;
    __syncthreads();
    if (tid < 128) tab[tid] = __builtin_amdgcn_cosf((float)tid * (1.f / 128.f));
    for (int c = tid; c < 64 * 128; c += NTHR) { const int kk = c >> 7, cc = c & 127; sW[kk * 129 + cc] = win[(size_t)(kt * 64 + kk) * 1536 + gq * 128 + cc]; }
    __syncthreads();
    const int kk = tid & 63; const float gk = gm[kt * 64 + kk];
    for (int i = 0; i < 4; ++i) {
      const int j = (tid >> 6) + 8 * (i + 4 * jq);
      float p = 0.f, qv = 0.f;
      for (int c = 0; c < 128; ++c) { const float wv = sW[kk * 129 + c]; const int m = (c * j) & 127; p += wv * tab[m]; qv += wv * tab[(m - 32) & 127]; }
      dst[(size_t)(gq * 128 + j) * 1024 + kt * 64 + kk] = f2bf(p * gk);
      dst[(size_t)(512 + gq * 128 + j) * 1024 + kt * 64 + kk] = f2bf(qv * gk);
    }
  }
}

#define XB_TMO      128
#define XB_XCNT(j)  (256  + 64 * (j))
#define XB_XSUB(j)  (1280 + 64 * (j))
#define XB_XGEN(j)  (2304 + 64 * (j))
#define XB_TOP      3328
#define XB_TOPGEN   3392
#define XCD_BAR_WORDS 3456
#define XB_SPIN_CAP (1u << 20)
DI unsigned xb_ld(unsigned* p)              { return __hip_atomic_load(p, __ATOMIC_RELAXED, __HIP_MEMORY_SCOPE_AGENT); }
DI unsigned xb_add(unsigned* p, unsigned v) { return __hip_atomic_fetch_add(p, v, __ATOMIC_RELAXED, __HIP_MEMORY_SCOPE_AGENT); }
DI unsigned xb_xcc_id() { return (unsigned)__builtin_amdgcn_s_getreg((3 << 11) | 20) & 0xFu; }
#define XB_SPIN(cond, bar) do { unsigned _sp = 0; while (cond) { __builtin_amdgcn_s_sleep(1); \
    if ((++_sp & 255u) == 0u) { if (xb_ld(&(bar)[XB_TMO])) break; if (_sp > XB_SPIN_CAP) { atomicAdd(&(bar)[XB_TMO], 1u); break; } } } } while (0)
struct XcdBarrier { unsigned* bar; unsigned x; volatile PG8_LAS unsigned* st; };
DI XcdBarrier xcd_barrier_post(unsigned* bar, volatile PG8_LAS unsigned* st) {
    XcdBarrier b; b.bar = bar; b.x = xb_xcc_id(); b.st = st;
    if (threadIdx.x == 0) { const unsigned rank = xb_add(&bar[XB_XCNT(b.x)], 1u); st[2] = rank; st[3] = b.x; }
    return b;
}
DI void xcd_barrier_complete(unsigned* bar, unsigned x, unsigned& nloc, unsigned& nx) {
    const unsigned G = gridDim.x * gridDim.y * gridDim.z;
    unsigned sum, cnt, mine, sp = 0u;
    for (;;) {
        sum = 0u; cnt = 0u; mine = 0u;
#pragma unroll
        for (unsigned j = 0; j < 16; ++j) { const unsigned c = xb_ld(&bar[XB_XCNT(j)]); sum += c; cnt += (c > 0u) ? 1u : 0u; mine = (j == x) ? c : mine; }
        if (sum == G) break;
        __builtin_amdgcn_s_sleep(1);
        if ((++sp & 255u) == 0u) { if (xb_ld(&bar[XB_TMO])) break; if (sp > XB_SPIN_CAP) { atomicAdd(&bar[XB_TMO], 1u); break; } }
    }
    nloc = mine > 0u ? mine : 1u; nx = cnt > 0u ? cnt : 1u;
}
DI void xcd_barrier(const XcdBarrier& b, const int wv__) {
    asm volatile("s_waitcnt vmcnt(0)" ::: "memory");
    __syncthreads();
    if (is_t0()) {
        unsigned* bar = b.bar;
        __builtin_amdgcn_s_waitcnt(0);
        unsigned nloc = b.st[0], nx = b.st[1];
        if (nloc == 0u) { xcd_barrier_complete(bar, b.x, nloc, nx); b.st[0] = nloc; b.st[1] = nx; }
        const unsigned old = xb_add(&bar[XB_XSUB(b.x)], 1u);
        const unsigned gen = old / nloc;
        if (old + 1u == (gen + 1u) * nloc) {
            __builtin_amdgcn_fence(__ATOMIC_RELEASE, "agent");
            asm volatile("s_waitcnt vmcnt(0)" ::: "memory");
            const unsigned og = xb_add(&bar[XB_TOP], 1u);
            const unsigned tg = og / nx;
            if (og + 1u == (tg + 1u) * nx) xb_add(&bar[XB_TOPGEN], 1u);
            else XB_SPIN(xb_ld(&bar[XB_TOPGEN]) == tg, bar);
            __builtin_amdgcn_fence(__ATOMIC_ACQUIRE, "agent");
            xb_add(&bar[XB_XGEN(b.x)], 1u);
            asm volatile("s_waitcnt vmcnt(0)" ::: "memory");
        } else {
            XB_SPIN(xb_ld(&bar[XB_XGEN(b.x)]) == gen, bar);
            __builtin_amdgcn_fence(__ATOMIC_ACQUIRE, "agent");
            asm volatile("s_waitcnt vmcnt(0)" ::: "memory");
        }
    }
    __syncthreads();
}

#define XB ((bf16_t*)(wsb + OFF_XB))
#define SSQ ((float*)(wsb + OFF_SSQ))
#define ROPE ((const float2*)(wsb + OFF_ROPE))
#define DFT ((bf16_t*)(wsb + OFF_DFT))
#define MEMN ((bf16_t*)(wsb + OFF_MEMN))
#define MEMK ((bf16_t*)(wsb + OFF_MEMK))
#define MEMVT ((bf16_t*)(wsb + OFF_MEMVT))
#define RR_ (wsb + OFF_R)
#define WGU1 ((bf16_t*)(wsb + OFF_WGU1))
#define WD1 ((bf16_t*)(wsb + OFF_WD1))
#define WGU2 ((bf16_t*)(wsb + OFF_WGU2))
#define WD2 ((bf16_t*)(wsb + OFF_WD2))
#define WXQ ((bf16_t*)(wsb + OFF_WXQ))
#define WXKV ((bf16_t*)(wsb + OFF_WXKV))
#define WXO ((bf16_t*)(wsb + OFF_WXO))
#define WMIX (wsb + OFF_WMIX)
#define SITE(s) (SSQ + (size_t)((s) & 3) * SLOT)
#define SQQ (SSQ + (size_t)(4 + 2 * li) * SLOT)
#define SQKV (SSQ + (size_t)(5 + 2 * li) * SLOT)
#define PQT ((bf16_t*)(RR_ + R_PQT))
#define HC ((bf16_t*)(RR_ + R_HCONV))
#define YAB ((bf16_t*)(RR_ + R_YAB))
#define UU ((bf16_t*)(RR_ + R_U))
#define QQ ((bf16_t*)(RR_ + R_Q))
#define KN ((bf16_t*)(RR_ + R_KN))
#define VT ((bf16_t*)(RR_ + R_VT))
#define OO ((bf16_t*)(RR_ + R_O))
#define QX ((bf16_t*)(RR_ + R_QX))
#define OX ((bf16_t*)(RR_ + R_OX))

__global__ void __launch_bounds__(NTHR, 2) fwd_kernel(Params P) {
  extern __shared__ __attribute__((aligned(16))) unsigned char smem[];
  cg::grid_group grid = cg::this_grid();
  const int G = gridDim.x, bid = blockIdx.x;
  const int pb = P.pb, pe = P.pe;
  const int wv__ = __builtin_amdgcn_readfirstlane((int)(threadIdx.x >> 6));
  volatile PG8_LAS unsigned* xbst = (volatile PG8_LAS unsigned*)((PG8_LAS unsigned char*)smem + LDS_STAGE);
  if (threadIdx.x == 0) { xbst[0] = 0u; xbst[1] = 0u; }
  __syncthreads();
  const XcdBarrier xbar = xcd_barrier_post((unsigned*)(P.ws + OFF_BAR), xbst);
  int ph = 0;
#define PH_BEGIN if (ph >= pb && ph < pe) { unsigned char* wsb = opq(P.ws); float* X = (float*)opq((unsigned char*)P.out); const int tid = otid(); const int lane = tid & 63; (void)lane; (void)X; (void)wsb;
#define PH_END } ++ph; if (ph > pb && ph < pe) { if (ph == 1) { grid.sync(); \
      if (is_t0()) { const unsigned rank = xbst[2], x = xbst[3]; const unsigned per = (unsigned)G / 8u; bool okx = ((unsigned)G % 8u == 0u); \
        for (unsigned j = 0; j < 16; ++j) { const unsigned c_ = xb_ld((unsigned*)(P.ws + OFF_BAR) + XB_XCNT(j)); okx = okx && (c_ == (j < 8u ? per : 0u)); } \
        xbst[2] = okx ? rank * 8u + x : (unsigned)bid;         \
        xbst[3] = okx ? x * per + rank : (unsigned)bid; }      \
      __syncthreads(); } else xcd_barrier(xbar, wv__); }

  for (int l = 0; l < 4; ++l) {
    const int li = l >> 1; const bool even = ((l & 1) == 0);
    PH_BEGIN
      if (even) wpq_job(P.in[18] + (size_t)li * 1024 * 1536, P.in[8] + l * 1024, (bf16_t*)(WMIX + WM_ABIN), smem, wv__);
      if (l == 0) {
        const int wv = tid >> 6;
        for (int row = bid * NWV + wv; row < T; row += G * NWV) {
          const float* src = (row < 16384) ? (P.in[0] + (size_t)row * 1024) : (P.in[1] + (size_t)(row - 16384) * 1024);
          float ss = 0.f;
#pragma unroll
          for (int i = 0; i < 4; ++i) {
            const int c = (i * 64 + lane) * 4;
            const float4 v = *(const float4*)(src + c);
            u32x2 pk = {pack2(v.x, v.y), pack2(v.z, v.w)};
            *(u32x2*)(XB + (size_t)row * 1024 + c) = pk;
            const float r0 = __uint_as_float(pk[0] << 16), r1 = __uint_as_float(pk[0] & 0xffff0000u), r2 = __uint_as_float(pk[1] << 16), r3 = __uint_as_float(pk[1] & 0xffff0000u);
            ss += r0 * r0 + r1 * r1 + r2 * r2 + r3 * r3;
          }
#pragma unroll
          for (int m = 1; m < 64; m <<= 1) ss += shx(ss, m);
          if (lane < 16) SITE(0)[(size_t)row * 16 + lane] = (lane == 0) ? ss : 0.f;
        }
        for (size_t i = (size_t)bid * NTHR + tid; i < 4 * SLOT; i += (size_t)G * NTHR) SSQ[4 * SLOT + i] = 0.f;
        for (int row = bid * NWV + wv; row < MEMT; row += G * NWV) {
          const float* src = (row < 2048) ? (P.in[2] + (size_t)row * 1024) : (P.in[3] + (size_t)(row - 2048) * 1024);
          float4 v[4]; float ss = 0.f;
#pragma unroll
          for (int i = 0; i < 4; ++i) { v[i] = *(const float4*)(src + (i * 64 + lane) * 4); ss += v[i].x * v[i].x + v[i].y * v[i].y + v[i].z * v[i].z + v[i].w * v[i].w; }
#pragma unroll
          for (int m = 1; m < 64; m <<= 1) ss += shx(ss, m);
          const float rs = rsqrtf(ss * (1.f / 1024.f) + EPS);
#pragma unroll
          for (int i = 0; i < 4; ++i) { u32x2 pk = {pack2(v[i].x * rs, v[i].y * rs), pack2(v[i].z * rs, v[i].w * rs)}; *(u32x2*)(MEMN + (size_t)row * 1024 + (i * 64 + lane) * 4) = pk; }
        }
        for (int i = bid * NTHR + tid; i < 2048 * 32; i += G * NTHR) {
          const int pos = i >> 5, fi = i & 31;
          const float inv_freq = __builtin_amdgcn_exp2f(-13.287712379549449f * (float)(2 * fi) * (1.f / 64.f));
          const float ang = (float)pos * inv_freq;
          const float kq = rintf(ang * 0.15915494309189535f);
          float rem = fmaf(-kq, 6.28125f, ang); rem = fmaf(-kq, 1.9353071795864769e-3f, rem);
          const float rev = rem * 0.15915494309189535f;
          ((float2*)(wsb + OFF_ROPE))[i] = make_float2(__builtin_amdgcn_cosf(rev), __builtin_amdgcn_sinf(rev));
        }
        for (int i = bid * NTHR + tid; i < 2048 * 2048; i += G * NTHR) {
          const int s = i >> 11, t = i & 2047;
          const int m = (s * t) & 2047;
          const float rev = (float)m * (1.f / 2048.f);
          DFT[(size_t)s * 4096 + t] = f2bf(__builtin_amdgcn_cosf(rev));
          DFT[(size_t)s * 4096 + 2048 + t] = f2bf(-__builtin_amdgcn_sinf(rev));
        }
      }
      {
        const size_t o_gu = (size_t)l * 1024 * 2816, o_sq = (size_t)l * 1024 * 1024;
        wconv_job(P.in[5] + o_gu, P.in[6] + o_gu, 2816, P.in[4] + l * 1024, WGU1, 5632, 1024, WM_GLU, 0, smem, 0, wv__);
        wconv_job(P.in[7] + o_gu, nullptr, 1024, nullptr, WD1, 1024, 2816, WM_ID, 0, smem, 704, wv__);
        wconv_job(P.in[15] + o_gu, P.in[16] + o_gu, 2816, P.in[14] + l * 1024, WGU2, 5632, 1024, WM_GLU, 0, smem, 1056, wv__);
        wconv_job(P.in[17] + o_gu, nullptr, 1024, nullptr, WD2, 1024, 2816, WM_ID, 0, smem, 1760, wv__);
        wconv_job(P.in[11] + o_sq, nullptr, 1024, P.in[9] + l * 1024, WXQ, 1024, 1024, WM_ID, 0, smem, 2112, wv__);
        wconv_job(P.in[12] + 2 * o_sq, nullptr, 2048, P.in[10] + l * 1024, WXKV, 2048, 1024, WM_ID, 0, smem, 2240, wv__);
        wconv_job(P.in[13] + o_sq, nullptr, 1024, nullptr, WXO, 1024, 1024, WM_ID, 0, smem, 2496, wv__);
        if (even) {
          const float* win = P.in[18] + (size_t)li * 1024 * 1536;
          wconv_job(win + 512, win + 1024, 1536, P.in[8] + l * 1024, (bf16_t*)(WMIX + WM_ABIN) + (size_t)1024 * 1024, 1024, 1024, WM_GLU, 0, smem, 2624, wv__);
          wconv_job(P.in[23] + (size_t)li * 1024 * 1024, nullptr, 1024, nullptr, (bf16_t*)(WMIX + WM_ABOUT), 1024, 1024, WM_ID, 0, smem, 2752, wv__);
        } else {
          wconv_job(P.in[24] + (size_t)li * 1024 * 832, nullptr, 832, P.in[8] + l * 1024, (bf16_t*)(WMIX + WM_MLAIN), 1024, 1024, WM_MLAINP, 0, smem, 2624, wv__);
          wconv_job(P.in[26] + (size_t)li * 512 * 1536, nullptr, 1536, P.in[25] + li * 512, (bf16_t*)(WMIX + WM_QB), 1536, 512, WM_QBP, 0, smem, 2752, wv__);
          wconv_job(P.in[28] + (size_t)li * 256 * 2048, nullptr, 2048, P.in[27] + li * 256, (bf16_t*)(WMIX + WM_KN), 1024, 256, WM_KVS, 0, smem, 2848, wv__);
          wconv_job(P.in[28] + (size_t)li * 256 * 2048, nullptr, 2048, P.in[27] + li * 256, (bf16_t*)(WMIX + WM_V), 1024, 256, WM_KVS, 128, smem, 2880, wv__);
          wconv_job(P.in[29] + (size_t)li * 1024 * 1024, nullptr, 1024, nullptr, (bf16_t*)(WMIX + WM_MLAOUT), 1024, 1024, WM_ID, 0, smem, 2912, wv__);
        }
      }
    PH_END

    PH_BEGIN
      { EpiArgs e{}; e.p0 = RR_; e.i0 = FF; e.ssq = SITE(4 * l + 0); e.f1 = 1.f / 1024.f;
        gemm_job_<EPI_SWIGLU>(XB, 1024, WGU1, 1024, T, 5632, 1024, e, smem, 0, wv__); }
      { EpiArgs e{}; e.p0 = MEMK; e.i0 = 1024; e.ssq = nullptr; e.f0 = 1.f;
        gemm_job_<EPI_STORE>(MEMN, 1024, WXKV, 1024, MEMT, 1024, 1024, e, smem, 4224, wv__); }
      { EpiArgs e{}; e.p0 = MEMVT;
        gemm_job_<EPI_MEMVT>(WXKV + (size_t)1024 * 1024, 1024, MEMN, 1024, 1024, MEMT, 1024, e, smem, 4224 + 96, wv__); }
    PH_END
    PH_BEGIN
      { EpiArgs e{}; e.p0 = X; e.p1 = XB; e.p2 = SITE(4 * l + 1); e.f0 = 0.5f;
        gemm_job_<EPI_RESID>((const bf16_t*)RR_, FF, WD1, FF, T, 1024, FF, e, smem, 0, wv__); }
    PH_END

    if (even) {
      PH_BEGIN
        { EpiArgs e{}; e.p0 = PQT; e.ssq = SITE(4 * l + 1); e.f1 = 1.f / 1024.f;
          gemm_job_<EPI_PQT>((const bf16_t*)(WMIX + WM_ABIN), 1024, XB, 1024, 1024, T, 1024, e, smem, 0, wv__); }
        { EpiArgs e{}; e.p0 = HC; e.i0 = 512; e.ssq = SITE(4 * l + 1); e.f1 = 1.f / 1024.f;
          gemm_job_<EPI_GLUAB>(XB, 1024, (const bf16_t*)(WMIX + WM_ABIN) + (size_t)1024 * 1024, 1024, T, 1024, 1024, e, smem, 0, wv__); }
      PH_END
      PH_BEGIN
        { EpiArgs e{}; e.p0 = YAB; e.f0 = 1.f / 512.f;
          gemm_job_<EPI_FOUR>(DFT, 4096, PQT, 4096, 2048, NSEQ * 512, 4096, e, smem, 0, wv__); }
        {
          const float* cw = P.in[19] + (size_t)li * 31 * 512; const float* cb = P.in[20] + li * 512;
          const float* lg = P.in[21] + li * 512; const float* lb = P.in[22] + li * 512;
          const int cidc = __builtin_amdgcn_readfirstlane((int)xbst[2]);
          if (G == 256) { if (cidc >= 128) for (int u = cidc - 128; u < NSEQ * 64; u += 128) conv_unit(HC, cw, cb, lg, lb, YAB, u >> 6, u & 63, smem, wv__); }
          else for (int u = bid; u < NSEQ * 64; u += G) conv_unit(HC, cw, cb, lg, lb, YAB, u >> 6, u & 63, smem, wv__);
        }
      PH_END
      PH_BEGIN
        { EpiArgs e{}; e.p0 = X; e.p1 = XB; e.p2 = SITE(4 * l + 2); e.f0 = 1.f;
          gemm_job_<EPI_RESID>(YAB, 1024, (const bf16_t*)(WMIX + WM_ABOUT), 1024, T, 1024, 1024, e, smem, 0, wv__); }
      PH_END
    } else {
      PH_BEGIN
        { EpiArgs e{}; e.p0 = UU; e.p1 = SQQ; e.p2 = SQKV; e.ssq = SITE(4 * l + 1); e.f1 = 1.f / 1024.f; e.rope = ROPE;
          gemm_job_<EPI_MLAIN>(XB, 1024, (const bf16_t*)(WMIX + WM_MLAIN), 1024, T, 1024, 1024, e, smem, 0, wv__); }
      PH_END
      for (int pt = 0; pt < 3; ++pt) {
        const size_t ro = (size_t)pt * PT;
        PH_BEGIN
          if (pt > 0) { const size_t rp = ro - PT;
            EpiArgs e{}; e.p0 = X + rp * 1024; e.p1 = XB + rp * 1024; e.p2 = SITE(4 * l + 2) + rp * 16; e.f0 = 1.f;
            gemm_job_<EPI_RESID>(OO, 1024, (const bf16_t*)(WMIX + WM_MLAOUT), 1024, PT, 1024, 1024, e, smem, 0, wv__); }
          { EpiArgs e{}; e.p0 = QQ; e.ssq = SQQ + ro * 16; e.f1 = 1.f / 512.f; e.f0 = 1.4426950408889634f * 0.07216878364870322f; e.rope = ROPE;
            gemm_job_<EPI_Q>(UU + ro * 896, 896, (const bf16_t*)(WMIX + WM_QB), 512, PT, 1536, 512, e, smem, 0, wv__); }
          { EpiArgs e{}; e.p0 = KN; e.i0 = 1024; e.ssq = SQKV + ro * 16; e.f1 = 1.f / 256.f; e.f0 = 1.f;
            gemm_job_<EPI_STORE>(UU + ro * 896 + 512, 896, (const bf16_t*)(WMIX + WM_KN), 256, PT, 1024, 256, e, smem, -128, wv__); }
          { EpiArgs e{}; e.p0 = VT; e.ssq = SQKV + ro * 16; e.f1 = 1.f / 256.f;
            gemm_job_<EPI_VT>((const bf16_t*)(WMIX + WM_V), 256, UU + ro * 896 + 512, 896, 1024, PT, 256, e, smem, 0, wv__); }
        PH_END
        PH_BEGIN
          for (int u = __builtin_amdgcn_readfirstlane((int)xbst[3]); u < 8 * 8 * 8; u += G) {
            const int qt = u & 7, hh = (u >> 3) & 7, b = u >> 6;
            attn_unit<192, 128, 128>(QQ + ((size_t)b * 2048 + qt * 256) * 1536 + hh * 192, 1536,
                                     KN + (size_t)b * 2048 * 1024 + hh * 128, 1024, UU + (ro + (size_t)b * 2048) * 896 + 768, 896,
                                     VT + ((size_t)(b * 8 + hh) * 128) * 2048, 2048, 2048,
                                     OO + ((size_t)b * 2048 + qt * 256) * 1024 + hh * 128, 1024, smem, wv__);
          }
        PH_END
      }
      PH_BEGIN
        { const size_t rp = (size_t)2 * PT;
          EpiArgs e{}; e.p0 = X + rp * 1024; e.p1 = XB + rp * 1024; e.p2 = SITE(4 * l + 2) + rp * 16; e.f0 = 1.f;
          gemm_job_<EPI_RESID>(OO, 1024, (const bf16_t*)(WMIX + WM_MLAOUT), 1024, PT, 1024, 1024, e, smem, 0, wv__); }
      PH_END
    }

    PH_BEGIN
      { EpiArgs e{}; e.p0 = QX; e.i0 = 1024; e.ssq = SITE(4 * l + 2); e.f1 = 1.f / 1024.f; e.f0 = 1.4426950408889634f * 0.0625f;
        gemm_job_<EPI_STORE>(XB, 1024, WXQ, 1024, T, 1024, 1024, e, smem, 0, wv__); }
    PH_END
    PH_BEGIN
      for (int u = __builtin_amdgcn_readfirstlane((int)xbst[3]); u < NSEQ * 4 * 2 * 8; u += G) {
        const int qt = u & 7, dvc = (u >> 3) & 1, hh = (u >> 4) & 3, b = u >> 6;
        attn_unit<256, 256, 128>(QX + ((size_t)b * 2048 + qt * 256) * 1024 + hh * 256, 1024,
                                MEMK + (size_t)b * 256 * 1024 + hh * 256, 1024, nullptr, 0,
                                MEMVT + ((size_t)(b * 4 + hh) * 256 + dvc * 128) * 256, 256, 256,
                                OX + ((size_t)b * 2048 + qt * 256) * 1024 + hh * 256 + dvc * 128, 1024, smem, wv__);
      }
    PH_END
    PH_BEGIN
      { EpiArgs e{}; e.p0 = X; e.p1 = XB; e.p2 = SITE(4 * l + 3); e.f0 = 1.f;
        gemm_job_<EPI_RESID>(OX, 1024, WXO, 1024, T, 1024, 1024, e, smem, 0, wv__); }
    PH_END
    PH_BEGIN
      { EpiArgs e{}; e.p0 = RR_; e.i0 = FF; e.ssq = SITE(4 * l + 3); e.f1 = 1.f / 1024.f;
        gemm_job_<EPI_SWIGLU>(XB, 1024, WGU2, 1024, T, 5632, 1024, e, smem, 0, wv__); }
    PH_END
    PH_BEGIN
      { EpiArgs e{}; e.p0 = X; e.p1 = XB; e.p2 = SITE(4 * l + 4); e.f0 = 0.5f;
        gemm_job_<EPI_RESID>((const bf16_t*)RR_, FF, WD2, FF, T, 1024, FF, e, smem, 0, wv__); }
    PH_END
  }
  PH_BEGIN
    {
      const int wv = tid >> 6; const float* fg = P.in[30]; const float* sq = SITE(16);
      for (int row = bid * NWV + wv; row < T; row += G * NWV) {
        const float rs = rstd16(sq, (size_t)row, 1.f / 1024.f);
#pragma unroll
        for (int i = 0; i < 4; ++i) {
          const int c = (i * 64 + lane) * 4;
          const u32x2 xv = *(const u32x2*)(XB + (size_t)row * 1024 + c); const float4 g = *(const float4*)(fg + c);
          float4 v;
          v.x = __uint_as_float(xv[0] << 16) * rs * g.x; v.y = __uint_as_float(xv[0] & 0xffff0000u) * rs * g.y;
          v.z = __uint_as_float(xv[1] << 16) * rs * g.z; v.w = __uint_as_float(xv[1] & 0xffff0000u) * rs * g.w;
          *(float4*)(X + (size_t)row * 1024 + c) = v;
        }
      }
    }
  PH_END
#undef PH_BEGIN
#undef PH_END
}

constexpr int NPHASES = 2 * 11 + 2 * 16 + 1;

extern "C" void kernel_launch(void* const* d_in, const int* in_sizes, int n_in, void* d_out, int out_size, void* d_ws, size_t ws_size, hipStream_t stream) {
  static int grid_blocks = 0;
  if (grid_blocks == 0) {
    if (n_in != 31 || ws_size < WS_NEED) { fprintf(stderr, "kernel_launch: bad n_in %d or ws_size %zu < %zu\n", n_in, ws_size, (size_t)WS_NEED); grid_blocks = -1; return; }
    int dev = 0, cus = 0, per_cu = 0;
    (void)hipGetDevice(&dev);
    (void)hipDeviceGetAttribute(&cus, hipDeviceAttributeMultiprocessorCount, dev);
    if (hipFuncSetAttribute((const void*)fwd_kernel, hipFuncAttributeMaxDynamicSharedMemorySize, LDS_BYTES) != hipSuccess) { fprintf(stderr, "hipFuncSetAttribute failed\n"); grid_blocks = -1; return; }
    (void)hipOccupancyMaxActiveBlocksPerMultiprocessor(&per_cu, (const void*)fwd_kernel, NTHR, LDS_BYTES);
    if (per_cu < 1) { fprintf(stderr, "occupancy query says %d\n", per_cu); per_cu = 1; }
    grid_blocks = cus;
    fprintf(stderr, "kernel_launch: cus %d per_cu %d grid %d\n", cus, per_cu, grid_blocks);
  }
  if (grid_blocks < 0) return;
  Params p{};
  for (int i = 0; i < 31; ++i) p.in[i] = (const float*)d_in[i];
  p.out = (float*)d_out; p.ws = (unsigned char*)d_ws;
  if (hipMemsetAsync((char*)d_ws + OFF_BAR, 0, 16384, stream) != hipSuccess) { fprintf(stderr, "memset of barrier words failed\n"); return; }
  p.pb = 0; p.pe = NPHASES;
  void* args[] = {&p};
  hipError_t e = hipLaunchCooperativeKernel((const void*)fwd_kernel, dim3(grid_blocks), dim3(NTHR), args, LDS_BYTES, stream);
  if (e != hipSuccess) fprintf(stderr, "cooperative launch failed: %s (grid %d)\n", hipGetErrorString(e), grid_blocks);
}
```

```cpp
#include <hip/hip_runtime.h>
#include <hip/hip_cooperative_groups.h>
#include <cstdio>
#include <cstdint>
#include <utility>
namespace cg = cooperative_groups;

#ifndef MULTI_LAUNCH
#define MULTI_LAUNCH 0
#endif

#define DI __device__ __forceinline__
#define PG8_LAS __attribute__((address_space(3)))
#define GAS __attribute__((address_space(1)))
typedef unsigned short bf16_t;
typedef short bf16x8 __attribute__((ext_vector_type(8)));
typedef float f32x4 __attribute__((ext_vector_type(4)));
typedef float f32x16 __attribute__((ext_vector_type(16)));
typedef unsigned u32x4 __attribute__((ext_vector_type(4)));
typedef unsigned u32x2 __attribute__((ext_vector_type(2)));
#define MFMA32(a, b, c) __builtin_amdgcn_mfma_f32_32x32x16_bf16((a), (b), (c), 0, 0, 0)

constexpr int T = 49152, FF = 2816, SEQ = 2048, NSEQ = 24, MEMT = 6144;
constexpr int PT = 16384;
constexpr float EPS = 1e-6f;
constexpr int NTHR = 512, NWV = 8;
constexpr int LDS_STAGE = 131072;
constexpr int RS_OFF = LDS_STAGE + 16;
constexpr int RSC_OFF = RS_OFF + 16384;
constexpr int LDS_BYTES = RSC_OFF + 1024;

constexpr size_t SZ_WGU = (size_t)5632 * 1024 * 2, SZ_WD = (size_t)1024 * 2816 * 2;
constexpr size_t OFF_WGU1 = 0, OFF_WD1 = OFF_WGU1 + SZ_WGU, OFF_WGU2 = OFF_WD1 + SZ_WD, OFF_WD2 = OFF_WGU2 + SZ_WGU;
constexpr size_t OFF_WXQ = OFF_WD2 + SZ_WD, OFF_WXKV = OFF_WXQ + 2097152, OFF_WXO = OFF_WXKV + 4194304;
constexpr size_t OFF_WMIX = OFF_WXO + 2097152;
constexpr size_t WM_ABIN = 0, WM_ABOUT = 4194304;
constexpr size_t WM_MLAIN = 0, WM_QB = 2097152, WM_KN = 3670016, WM_V = 4194304, WM_MLAOUT = 4718592;
constexpr size_t OFF_DFT = OFF_WMIX + 6815744;
constexpr size_t OFF_ROPE = OFF_DFT + 16777216;
constexpr size_t OFF_SSQ = OFF_ROPE + 524288;
constexpr size_t SLOT = (size_t)T * 16;
constexpr size_t OFF_MEMN = OFF_SSQ + 8 * SLOT * 4;
constexpr size_t OFF_MEMK = OFF_MEMN + 12582912, OFF_MEMVT = OFF_MEMK + 12582912;
constexpr size_t OFF_XB = OFF_MEMVT + 12582912;
constexpr size_t OFF_R = OFF_XB + (size_t)T * 1024 * 2;
constexpr size_t OFF_BAR = OFF_R + (size_t)T * 2816 * 2;
constexpr size_t WS_NEED = OFF_BAR + 16384;
constexpr size_t R_PQT = 0, R_HCONV = 100663296, R_YAB = 150994944;
constexpr size_t R_U = 0, R_Q = 88080384, R_KN = 138412032, R_VT = 171966464, R_O = 205520896;
constexpr size_t R_QX = 0, R_OX = 100663296;

struct Params { const float* in[31]; float* out; unsigned char* ws; int pb, pe; };

DI unsigned short f2bf(float x) { unsigned u = __float_as_uint(x); u += 0x7fffu + ((u >> 16) & 1u); return (unsigned short)(u >> 16); }
typedef __bf16 bf16x2_t __attribute__((ext_vector_type(2)));
typedef float f32x2_t __attribute__((ext_vector_type(2)));
DI unsigned pack2(float a, float b) { f32x2_t v = {a, b}; bf16x2_t r = __builtin_convertvector(v, bf16x2_t); return __builtin_bit_cast(unsigned, r); }
DI int lane_asm_() { int t; asm volatile("v_mbcnt_lo_u32_b32 %0, -1, 0\n\tv_mbcnt_hi_u32_b32 %0, -1, %0" : "=v"(t)); return t; }
DI int otid_(int wv) { return (wv << 6) | lane_asm_(); }
#define otid() otid_(wv__)
DI float xsum32(float v) { auto r = __builtin_amdgcn_permlane32_swap(__float_as_uint(v), __float_as_uint(v), false, false); return __uint_as_float(r[0]) + __uint_as_float(r[1]); }
DI float xmax32(float v) { auto r = __builtin_amdgcn_permlane32_swap(__float_as_uint(v), __float_as_uint(v), false, false); return fmaxf(__uint_as_float(r[0]), __uint_as_float(r[1])); }
DI float xsum16(float v) { auto r = __builtin_amdgcn_permlane16_swap(__float_as_uint(v), __float_as_uint(v), false, false); return __uint_as_float(r[0]) + __uint_as_float(r[1]); }
#define DPP_ADD(v, ctrl) ((v) + __int_as_float(__builtin_amdgcn_mov_dpp(__float_as_int(v), (ctrl), 0xf, 0xf, true)))
DI float wsum64(float v) { v = DPP_ADD(v, 0xB1); v = DPP_ADD(v, 0x4E); v = DPP_ADD(v, 0x141); v = DPP_ADD(v, 0x140); v = xsum16(v); return xsum32(v); }
DI float shx(float v, int m) { const int l = lane_asm_(); return __int_as_float(__builtin_amdgcn_ds_bpermute((l ^ m) << 2, __float_as_int(v))); }
DI bool is_t0_(int wv) { return wv == 0 && lane_asm_() == 0; }
#define is_t0() is_t0_(wv__)
DI unsigned char* opq(unsigned char* p) { asm volatile("" : "+s"(p)); return p; }
DI float rstd16(const float* ssq, size_t row, float invd) {
  const float4 a = *(const float4*)(ssq + row * 16), b = *(const float4*)(ssq + row * 16 + 4), c = *(const float4*)(ssq + row * 16 + 8), d = *(const float4*)(ssq + row * 16 + 12);
  const float sm = (((a.x + a.y) + (a.z + a.w)) + ((b.x + b.y) + (b.z + b.w))) + (((c.x + c.y) + (c.z + c.w)) + ((d.x + d.y) + (d.z + d.w)));
  return rsqrtf(sm * invd + EPS);
}
DI int crow(int i, int h) { return (i & 3) + 8 * (i >> 2) + 4 * h; }
DI float sigmoidf_(float x) { return __builtin_amdgcn_rcpf(1.f + __builtin_amdgcn_exp2f(-1.4426950408889634f * x)); }
DI u32x4 pk8v(const f32x4& a, const f32x4& b) { u32x4 w = {pack2(a[0], a[1]), pack2(a[2], a[3]), pack2(b[0], b[1]), pack2(b[2], b[3])}; return w; }
DI u32x4 pk8(const float* v) { u32x4 pk = {pack2(v[0], v[1]), pack2(v[2], v[3]), pack2(v[4], v[5]), pack2(v[6], v[7])}; return pk; }
DI void rope8(float* v, const float2* rope, int pos, int i0) {
#pragma unroll
  for (int j = 0; j < 4; ++j) { float2 cs = rope[pos * 32 + i0 + j]; float x1 = v[2 * j], x2 = v[2 * j + 1]; v[2 * j] = x1 * cs.x - x2 * cs.y; v[2 * j + 1] = x1 * cs.y + x2 * cs.x; }
}

namespace pg8 {
constexpr int BM = 256, BK = 64, HALF = 128, HTB = HALF * BK * 2, STAGE_BYTES = 8 * HTB, NXCD = 8, WGM = 8;
__host__ __device__ __forceinline__ int lds_byte(int r, int c) { const int st = (r >> 4) * 2 + (c >> 5), rr = r & 15, cc = c & 31, ob = rr * 64 + cc * 2; return st * 1024 + (ob ^ (((ob >> 9) & 1) << 5)); }
__host__ __device__ __forceinline__ void stage_rc(int b, int& R, int& C) { const int st = b / 1024, sb = b % 1024, swz = sb ^ (((sb >> 9) & 1) << 5); R = (st >> 1) * 16 + swz / 64; C = (st & 1) * 32 + (swz % 64) / 2; }
__host__ __device__ __forceinline__ int perm32(int rho) { const int n = rho >> 4, i = rho & 15; return 8 * (i >> 2) + 4 * n + (i & 3); }
struct Unit { int pm, pn; };
struct Gemm { const bf16_t* A; const bf16_t* Bt; int M, N, K, lda, ldb; };
struct StaticOrder {
    int nM, nN, nwg, G, c;
    __host__ __device__ void init(int M, int N, int G_, int c_) { nM = M / BM; nN = N / BM; nwg = nM * nN; G = G_; c = c_; }
    __host__ __device__ bool next(int i, Unit& u) const {
        const long L = (long)i * G + c; if (L >= nwg) return false;
        int wgid = (int)L; { const int q = nwg / NXCD, r = nwg % NXCD, xcd = wgid % NXCD, off = wgid / NXCD; wgid = (xcd < r ? xcd * (q + 1) : r * (q + 1) + (xcd - r) * q) + off; }
        const int nig = WGM * nN, gid = wgid / nig, fm = gid * WGM, gsz = (nM - fm) < WGM ? (nM - fm) : WGM;
        u.pm = fm + ((wgid % nig) % gsz); u.pn = (wgid % nig) / gsz; return true;
    }
    __device__ __forceinline__ void a_ready(const Unit&) const {}
    __device__ __forceinline__ void done(const Unit&) const {}
};
template <class Epi, class Sched, bool STAMP = false>
__device__ __forceinline__ void gemm_phase(PG8_LAS unsigned char* lds, const Gemm g, const Sched& S, const Epi& E, unsigned long long* stamps, const int wv__) {
    const int tid = otid(), wid = __builtin_amdgcn_readfirstlane(tid >> 6), lane = tid & 63, wr = wid >> 2, wc = wid & 3, fr = lane & 15, fq = lane >> 4;
    const int K = g.K, nt = K / BK;
    int ts_lo = 0, ts_hi = 0, nts = 0; const unsigned long long rt_entry = STAMP ? (unsigned long long)wall_clock64() : 0ull;
#define PG8_STAMP() do { if (STAMP && wid == 0 && nts < 64) { const unsigned long long _c = (unsigned long long)clock64(); \
        ts_lo = (lane == nts) ? (int)(unsigned)_c : ts_lo; ts_hi = (lane == nts) ? (int)(unsigned)(_c >> 32) : ts_hi; ++nts; } } while (0)
    PG8_STAMP();
    unsigned voffA[2], voffB[2];
#pragma unroll
    for (int i = 0; i < 2; ++i) { int R, C; stage_rc(tid * 16 + i * 8192, R, C); const int Rb = Epi::PERM ? ((R & ~31) + perm32(R & 31)) : R;
        voffA[i] = (unsigned)(R * g.lda + C) * 2u; voffB[i] = (unsigned)(Rb * g.ldb + C) * 2u; }
    const size_t kstep = (size_t)(BK * 2);
    const size_t hstepA = (size_t)HALF * g.lda * 2, hstepB = (size_t)HALF * g.ldb * 2;
    const size_t tstepA = 2 * hstepA, tstepB = 2 * hstepB;
    const unsigned ldsw = (unsigned)wid * 1024u;
    const int aoff = lds_byte(wr * 64 + fr, fq * 8), boff = lds_byte(wc * 32 + fr, fq * 8);
#define PG8_SA(b, h) (((b) * 2 + (h)) * HTB)
#define PG8_SB(b, h) ((4 + (b) * 2 + (h)) * HTB)
#define PG8_STAGE(bufoff, gbase, voff) do { _Pragma("unroll") for (int _i = 0; _i < 2; ++_i) \
        __builtin_amdgcn_global_load_lds((const unsigned*)((const char*)(gbase) + (voff)[_i]), (PG8_LAS unsigned*)(lds + (bufoff) + ldsw + _i * 8192), 16, 0, 0); } while (0)
#define PG8_LDA(dst, b, h) do { _Pragma("unroll") for (int m = 0; m < 4; ++m) _Pragma("unroll") for (int k = 0; k < 2; ++k) dst[m][k] = *(const PG8_LAS bf16x8*)(lds + PG8_SA(b, h) + aoff + m * 2048 + k * 1024); } while (0)
#define PG8_LDB(dst, b, h) do { _Pragma("unroll") for (int n = 0; n < 2; ++n) _Pragma("unroll") for (int k = 0; k < 2; ++k) dst[n][k] = *(const PG8_LAS bf16x8*)(lds + PG8_SB(b, h) + boff + n * 2048 + k * 1024); } while (0)
#define PG8_MMA(ai, bj, At, Bt) do { __builtin_amdgcn_s_setprio(1); _Pragma("unroll") for (int m = 0; m < 4; ++m) _Pragma("unroll") for (int n = 0; n < 2; ++n) _Pragma("unroll") for (int k = 0; k < 2; ++k) \
        acc[ai][bj][m][n] = __builtin_amdgcn_mfma_f32_16x16x32_bf16(Bt[n][k], At[m][k], acc[ai][bj][m][n], 0, 0, 0); __builtin_amdgcn_s_setprio(0); } while (0)
#define PG8_WAIT_V(n) asm volatile("s_waitcnt vmcnt(" #n ")" ::: "memory")
#define PG8_WAIT_L(n) asm volatile("s_waitcnt lgkmcnt(" #n ")" ::: "memory")
#define PG8_BAR __builtin_amdgcn_s_barrier()
#define PG8_SCHED __builtin_amdgcn_sched_barrier(0)
    Unit cur, nxt; int ui = 0;
    if (!S.next(0, cur)) return;
    f32x4 acc[2][2][4][2];
    if constexpr (!Epi::ACC_INIT)
#pragma unroll
    for (int a = 0; a < 2; ++a)
#pragma unroll
        for (int b = 0; b < 2; ++b)
#pragma unroll
            for (int m = 0; m < 4; ++m)
#pragma unroll
                for (int n = 0; n < 2; ++n) acc[a][b][m][n] = (f32x4){0.f, 0.f, 0.f, 0.f};
    bf16x8 At[4][2], B0[2][2], B1[2][2];
    const char* cA = (const char*)g.A + (size_t)cur.pm * tstepA; const char* cB = (const char*)g.Bt + (size_t)cur.pn * tstepB;
    S.a_ready(cur);
    PG8_STAGE(PG8_SB(0, 0), cB, voffB); PG8_STAGE(PG8_SA(0, 0), cA, voffA); PG8_STAGE(PG8_SB(0, 1), cB + hstepB, voffB); PG8_STAGE(PG8_SA(0, 1), cA + hstepA, voffA);
    if (wr == 1) PG8_BAR;
    PG8_WAIT_V(4); PG8_BAR;
    PG8_STAGE(PG8_SB(1, 0), cB + kstep, voffB); PG8_STAGE(PG8_SA(1, 0), cA + kstep, voffA); PG8_STAGE(PG8_SB(1, 1), cB + hstepB + kstep, voffB);
    PG8_WAIT_V(6); PG8_BAR;
    PG8_STAMP();
    for (;;) {
        if constexpr (Epi::RSM != 0) { if (E.e.ssq) {
            const int rr_ = wr * 64 + (wc & 1) * 32 + (wc >> 1) * 128;
            const char* rb_ = (const char*)E.e.ssq + ((size_t)cur.pm * BM + rr_) * 64 + lane * 16;
            __builtin_amdgcn_global_load_lds((const unsigned*)rb_, (PG8_LAS unsigned*)(lds + RS_OFF + rr_ * 64), 16, 0, 0);
            __builtin_amdgcn_global_load_lds((const unsigned*)(rb_ + 1024), (PG8_LAS unsigned*)(lds + RS_OFF + rr_ * 64 + 1024), 16, 0, 0); } }
        if constexpr (Epi::ACC_INIT) E.init(acc, cur, wr, wc, fr, fq);
        const bool has_next = S.next(ui + 1, nxt);
        const char* nA = has_next ? (const char*)g.A + (size_t)nxt.pm * tstepA : cA; const char* nB = has_next ? (const char*)g.Bt + (size_t)nxt.pn * tstepB : cB;
        for (int t = 0; t < nt; t += 2) {
            const bool last = (t == nt - 2);
            const char* a1 = cA + (size_t)(t + 1) * kstep;
            const char* a2 = last ? nA : cA + (size_t)(t + 2) * kstep; const char* b2 = last ? nB : cB + (size_t)(t + 2) * kstep;
            const char* a3 = a2 + kstep; const char* b3 = b2 + kstep;
            if (last && has_next) S.a_ready(nxt);
            PG8_LDB(B0, 0, 0); PG8_SCHED; PG8_LDA(At, 0, 0); PG8_STAGE(PG8_SA(1, 1), a1 + hstepA, voffA);
            PG8_WAIT_L(8); PG8_BAR; PG8_WAIT_L(0); PG8_MMA(0, 0, At, B0); PG8_BAR; PG8_SCHED;
            PG8_LDB(B1, 0, 1); PG8_STAGE(PG8_SB(0, 0), b2, voffB);
            PG8_BAR; PG8_WAIT_L(0); PG8_MMA(0, 1, At, B1); PG8_BAR;
            PG8_LDA(At, 0, 1); PG8_STAGE(PG8_SA(0, 0), a2, voffA);
            PG8_BAR; PG8_WAIT_L(0); PG8_MMA(1, 0, At, B0); PG8_BAR; PG8_SCHED;
            PG8_STAGE(PG8_SB(0, 1), b2 + hstepB, voffB);
            PG8_WAIT_V(6); PG8_BAR; PG8_MMA(1, 1, At, B1); PG8_BAR;
            PG8_LDB(B0, 1, 0); PG8_SCHED; PG8_LDA(At, 1, 0); PG8_STAGE(PG8_SA(0, 1), a2 + hstepA, voffA);
            PG8_WAIT_L(8); PG8_BAR; PG8_WAIT_L(0); PG8_MMA(0, 0, At, B0); PG8_BAR; PG8_SCHED;
            PG8_LDB(B1, 1, 1); PG8_STAGE(PG8_SB(1, 0), b3, voffB);
            PG8_BAR; PG8_WAIT_L(0); PG8_MMA(0, 1, At, B1); PG8_BAR;
            PG8_LDA(At, 1, 1); PG8_STAGE(PG8_SA(1, 0), a3, voffA);
            PG8_BAR; PG8_WAIT_L(0); PG8_MMA(1, 0, At, B0); PG8_BAR; PG8_SCHED;
            PG8_STAGE(PG8_SB(1, 1), b3 + hstepB, voffB);
            PG8_WAIT_V(6); PG8_BAR; PG8_MMA(1, 1, At, B1); PG8_BAR;
        }
        PG8_STAMP();
        if constexpr (Epi::RSM != 0) { if (E.e.ssq) {
            const int t2 = tid & 255;
            if (t2 < 128) {
                const int rl = wr * 64 + (t2 & 63) + (t2 >> 6) * 128;
                const PG8_LAS f32x4* p = (const PG8_LAS f32x4*)(lds + RS_OFF + rl * 64);
                const f32x4 a = p[0], b = p[1], c = p[2], d = p[3];
                const float sm = (((a[0] + a[1]) + (a[2] + a[3])) + ((b[0] + b[1]) + (b[2] + b[3]))) + (((c[0] + c[1]) + (c[2] + c[3])) + ((d[0] + d[1]) + (d[2] + d[3])));
                *(PG8_LAS float*)(lds + RSC_OFF + rl * 4) = rsqrtf(sm * E.e.f1 + EPS);
            }
            PG8_WAIT_L(0); PG8_BAR;
        } }
        if constexpr (!Epi::AFTER_DRAIN) { E(acc, cur, wr, wc, fr, fq); S.done(cur); }
        PG8_STAMP();
        if (!has_next) break;
        if constexpr (!Epi::ACC_INIT)
#pragma unroll
        for (int a = 0; a < 2; ++a)
#pragma unroll
            for (int b = 0; b < 2; ++b)
#pragma unroll
                for (int m = 0; m < 4; ++m)
#pragma unroll
                    for (int n = 0; n < 2; ++n) acc[a][b][m][n] = (f32x4){0.f, 0.f, 0.f, 0.f};
        cur = nxt; cA = nA; cB = nB; ++ui;
    }
    PG8_WAIT_V(0);
    if (wr == 0) PG8_BAR;
    PG8_BAR;
    if constexpr (Epi::AFTER_DRAIN) { E.fused(acc, cur, wr, wc, fr, fq, lds, wid, lane); S.done(cur); }
    PG8_STAMP();
    if (STAMP && wid == 0) { stamps[lane] = lane < nts ? (((unsigned long long)(unsigned)ts_hi << 32) | (unsigned)ts_lo) : 0ull;
        if (lane == 62) stamps[62] = rt_entry; if (lane == 63) stamps[63] = (unsigned long long)wall_clock64(); }
#undef PG8_STAMP
#undef PG8_SA
#undef PG8_SB
#undef PG8_STAGE
#undef PG8_LDA
#undef PG8_LDB
#undef PG8_MMA
#undef PG8_WAIT_V
#undef PG8_WAIT_L
#undef PG8_BAR
#undef PG8_SCHED
}
}

enum { EPI_STORE = 0, EPI_FOUR, EPI_RESID, EPI_SWIGLU, EPI_GLUAB, EPI_PQT, EPI_VT, EPI_MEMVT, EPI_MLAIN, EPI_Q };
struct EpiArgs { void* p0; void* p1; void* p2; const float* ssq; const float2* rope; float f0; float f1; int i0; int i1; };

template <int EPI> struct EpiF {
  static constexpr bool PERM = true, AFTER_DRAIN = false;
  static constexpr int RSM = (EPI == EPI_STORE || EPI == EPI_SWIGLU || EPI == EPI_GLUAB || EPI == EPI_MLAIN || EPI == EPI_Q) ? 1 : 0;
  static constexpr bool ACC_INIT = (EPI == EPI_RESID);
  EpiArgs e; const PG8_LAS float* rsc;
  DI void init(f32x4 (&acc)[2][2][4][2], const pg8::Unit& u, int wr, int wc, int fr, int fq) const {
    if constexpr (EPI == EPI_RESID) {
      const GAS bf16_t* xb = (const GAS bf16_t*)e.p1; const float ia = 1.f / e.f0;
      const int rbase = u.pm * 256 + wr * 64 + fr, cbase = u.pn * 256 + wc * 32 + fq * 8;
      u32x4 xo[2][4][2];
#pragma unroll
      for (int ai = 0; ai < 2; ++ai)
#pragma unroll
        for (int m = 0; m < 4; ++m)
#pragma unroll
          for (int bj = 0; bj < 2; ++bj) xo[ai][m][bj] = *(const GAS u32x4*)(xb + (size_t)(rbase + ai * 128 + m * 16) * 1024 + cbase + bj * 128);
#pragma unroll
      for (int ai = 0; ai < 2; ++ai)
#pragma unroll
        for (int m = 0; m < 4; ++m)
#pragma unroll
          for (int bj = 0; bj < 2; ++bj)
#pragma unroll
            for (int j = 0; j < 4; ++j) {
              acc[ai][bj][m][j >> 1][(j & 1) * 2] = __uint_as_float(xo[ai][m][bj][j] << 16) * ia;
              acc[ai][bj][m][j >> 1][(j & 1) * 2 + 1] = __uint_as_float(xo[ai][m][bj][j] & 0xffff0000u) * ia;
            }
    }
  }
  DI void operator()(const f32x4 (&acc)[2][2][4][2], const pg8::Unit& u, int wr, int wc, int fr, int fq) const {
    const int rbase = u.pm * 256 + wr * 64 + fr;
    const int rloc = wr * 64 + fr;
    const int cbase = u.pn * 256 + wc * 32 + fq * 8;
    if constexpr (EPI == EPI_STORE) {
      GAS bf16_t* out = (GAS bf16_t*)e.p0; const int ldo = e.i0;
#pragma unroll
      for (int ai = 0; ai < 2; ++ai)
#pragma unroll
        for (int m = 0; m < 4; ++m) {
          const size_t row = (size_t)(rbase + ai * 128 + m * 16);
          float rs = e.f0; if (e.ssq) rs *= rsc[rloc + ai * 128 + m * 16];
#pragma unroll
          for (int bj = 0; bj < 2; ++bj) *(GAS u32x4*)(out + row * ldo + cbase + bj * 128) = pk8v(acc[ai][bj][m][0] * rs, acc[ai][bj][m][1] * rs);
        }
    } else if constexpr (EPI == EPI_FOUR) {
      GAS bf16_t* out = (GAS bf16_t*)e.p0;
#pragma unroll
      for (int ai = 0; ai < 2; ++ai)
#pragma unroll
        for (int m = 0; m < 4; ++m) {
          const int s = rbase + ai * 128 + m * 16;
#pragma unroll
          for (int bj = 0; bj < 2; ++bj) { const int col = cbase + bj * 128; const int b = col >> 9, ch = col & 511;
            *(GAS u32x4*)(out + ((size_t)b * 2048 + s) * 1024 + ch) = pk8v(acc[ai][bj][m][0] * e.f0, acc[ai][bj][m][1] * e.f0); }
        }
    } else if constexpr (EPI == EPI_RESID) {
      GAS bf16_t* xb = (GAS bf16_t*)e.p1; GAS float* ssqn = (GAS float*)e.p2;
#pragma unroll
      for (int ai = 0; ai < 2; ++ai)
#pragma unroll
        for (int m = 0; m < 4; ++m) {
          const size_t row = (size_t)(rbase + ai * 128 + m * 16);
          float ss = 0.f;
#pragma unroll
          for (int bj = 0; bj < 2; ++bj) {
            u32x4 xn;
#pragma unroll
            for (int j = 0; j < 4; ++j) {
              const unsigned pk = pack2(acc[ai][bj][m][j >> 1][(j & 1) * 2] * e.f0, acc[ai][bj][m][j >> 1][(j & 1) * 2 + 1] * e.f0);
              xn[j] = pk;
              const float r0 = __uint_as_float(pk << 16), r1 = __uint_as_float(pk & 0xffff0000u);
              ss += r0 * r0 + r1 * r1;
            }
            *(GAS u32x4*)(xb + row * 1024 + cbase + bj * 128) = xn;
          }
          ss = xsum16(ss); ss = xsum32(ss);
          if (fq == 0) ssqn[row * 16 + u.pn * 4 + wc] = ss;
        }
    } else if constexpr (EPI == EPI_SWIGLU || EPI == EPI_GLUAB) {
      GAS bf16_t* out = (GAS bf16_t*)e.p0; const int ldo = e.i0;
#pragma unroll
      for (int ai = 0; ai < 2; ++ai)
#pragma unroll
        for (int m = 0; m < 4; ++m) {
          const size_t row = (size_t)(rbase + ai * 128 + m * 16);
          const float rs = rsc[rloc + ai * 128 + m * 16];
          float v[8];
#pragma unroll
          for (int n = 0; n < 2; ++n)
#pragma unroll
            for (int j = 0; j < 4; ++j) {
              const float a = acc[ai][0][m][n][j] * rs, b = acc[ai][1][m][n][j] * rs;
              v[n * 4 + j] = (EPI == EPI_SWIGLU) ? (a * sigmoidf_(a) * b) : (a * sigmoidf_(b));
            }
          *(GAS u32x4*)(out + row * ldo + u.pn * 128 + wc * 32 + fq * 8) = pk8(v);
        }
    } else if constexpr (EPI == EPI_PQT || EPI == EPI_VT || EPI == EPI_MEMVT) {
      GAS bf16_t* out = (GAS bf16_t*)e.p0;
#pragma unroll
      for (int bj = 0; bj < 2; ++bj) {
        const int tok0 = cbase + bj * 128;
        float rs[8];
#pragma unroll
        for (int j = 0; j < 8; ++j) rs[j] = (EPI == EPI_MEMVT) ? 1.f : rstd16(e.ssq, (size_t)(tok0 + j), e.f1);
#pragma unroll
        for (int ai = 0; ai < 2; ++ai)
#pragma unroll
          for (int m = 0; m < 4; ++m) {
            const int n = rbase + ai * 128 + m * 16;
            size_t dst;
            if constexpr (EPI == EPI_PQT) { const int b = tok0 >> 11, pos = tok0 & 2047; dst = ((size_t)b * 512 + (n & 511)) * 4096 + (n >> 9) * 2048 + pos; }
            else if constexpr (EPI == EPI_VT) { const int b = tok0 >> 11, pos = tok0 & 2047; dst = ((size_t)b * 1024 + n) * 2048 + pos; }
            else { const int b = tok0 >> 8, mm = tok0 & 255; dst = ((size_t)b * 1024 + n) * 256 + mm; }
            float v[8];
#pragma unroll
            for (int nn = 0; nn < 2; ++nn)
#pragma unroll
              for (int j = 0; j < 4; ++j) v[nn * 4 + j] = acc[ai][bj][m][nn][j] * rs[nn * 4 + j];
            *(GAS u32x4*)(out + dst) = pk8(v);
          }
        __builtin_amdgcn_sched_barrier(0);
      }
    } else if constexpr (EPI == EPI_MLAIN) {
      GAS bf16_t* uo = (GAS bf16_t*)e.p0; GAS float* ssq_q = (GAS float*)e.p1; GAS float* ssq_kv = (GAS float*)e.p2;
#pragma unroll
      for (int ai = 0; ai < 2; ++ai)
#pragma unroll
        for (int m = 0; m < 4; ++m) {
          const size_t row = (size_t)(rbase + ai * 128 + m * 16);
          const float rs = rsc[rloc + ai * 128 + m * 16];
          float ss = 0.f;
#pragma unroll
          for (int bj = 0; bj < 2; ++bj) {
            const int col = cbase + bj * 128;
            float v[8];
#pragma unroll
            for (int nn = 0; nn < 2; ++nn)
#pragma unroll
              for (int j = 0; j < 4; ++j) { v[nn * 4 + j] = acc[ai][bj][m][nn][j] * rs; ss += v[nn * 4 + j] * v[nn * 4 + j]; }
            if (u.pn == 3) { if (col < 832) rope8(v, e.rope, (int)(row & 2047), (col - 768) >> 1); }
            if (col < 832) *(GAS u32x4*)(uo + row * 896 + col) = pk8(v);
          }
          if (u.pn < 3) {
            ss = xsum16(ss); ss = xsum32(ss);
            if (fq == 0) { if (u.pn < 2) ssq_q[row * 16 + u.pn * 4 + wc] = ss; else ssq_kv[row * 16 + wc] = ss; }
          }
        }
    } else if constexpr (EPI == EPI_Q) {
      GAS bf16_t* q = (GAS bf16_t*)e.p0;
#pragma unroll
      for (int ai = 0; ai < 2; ++ai)
#pragma unroll
        for (int m = 0; m < 4; ++m) {
          const size_t row = (size_t)(rbase + ai * 128 + m * 16);
          const float rs = rsc[rloc + ai * 128 + m * 16];
#pragma unroll
          for (int bj = 0; bj < 2; ++bj) {
            const int col = cbase + bj * 128; const int cc = col % 192;
            float v[8];
#pragma unroll
            for (int nn = 0; nn < 2; ++nn)
#pragma unroll
              for (int j = 0; j < 4; ++j) v[nn * 4 + j] = acc[ai][bj][m][nn][j] * rs;
            if (cc >= 128) rope8(v, e.rope, (int)(row & 2047), (cc - 128) >> 1);
#pragma unroll
            for (int j = 0; j < 8; ++j) v[j] *= e.f0;
            *(GAS u32x4*)(q + row * 1536 + col) = pk8(v);
          }
        }
    }
  }
};

template <int EPI>
DI void gemm_job_(const bf16_t* A, int lda, const bf16_t* Bt, int ldb, int M, int N, int K, const EpiArgs& ea, unsigned char* smem, int shift, const int wv__) {
  asm volatile("" : "+s"(K));
  pg8::Gemm g{A, Bt, M, N, K, lda, ldb};
  pg8::StaticOrder S; const int G = gridDim.x; const int cid = __builtin_amdgcn_readfirstlane((int)((volatile PG8_LAS unsigned*)((PG8_LAS unsigned char*)smem + LDS_STAGE))[2]);
  if (shift == -128 && G == 256) S.init(M, N, 128, cid >= 128 ? cid - 128 : (1 << 28));
  else S.init(M, N, G, (int)((cid + G - ((shift < 0 ? 0 : shift) % G)) % G));
  EpiF<EPI> E{ea, (const PG8_LAS float*)((PG8_LAS unsigned char*)smem + RSC_OFF)};
  pg8::gemm_phase<EpiF<EPI>, pg8::StaticOrder, false>((PG8_LAS unsigned char*)smem, g, S, E, nullptr, wv__);
  __syncthreads();
}

template <int DQK, int K0C, int DVC>
DI void attn_unit(const bf16_t* __restrict__ q, long ldq, const bf16_t* __restrict__ k0, long ldk0, const bf16_t* __restrict__ k1, long ldk1,
                  const bf16_t* __restrict__ vt, long ldvt, int nkeys, bf16_t* __restrict__ o, long ldo, unsigned char* smem, const int wv__) {
  constexpr int LDK = DQK + 8, CPR = DQK / 8, NKS = DQK / 16, ND = DVC / 32;
  constexpr int KIT = (64 * CPR) / NTHR, VIT = (DVC * 8) / NTHR;
  constexpr int KBYTES = 64 * LDK * 2, VBYTES = DVC * 72 * 2, BUFB = KBYTES + VBYTES;
  const int tid = otid(), lane = tid & 63, w = tid >> 6, r = lane & 31, h = lane >> 5;
  const GAS bf16_t* k0g = (const GAS bf16_t*)k0; const GAS bf16_t* k1g = (const GAS bf16_t*)k1; const GAS bf16_t* vtg = (const GAS bf16_t*)vt;
  bf16x8 bq[NKS];
  {
    const GAS bf16_t* qp = (const GAS bf16_t*)q + (long)(w * 32 + r) * ldq + h * 8;
#pragma unroll
    for (int ks = 0; ks < NKS; ++ks) bq[ks] = *(const GAS bf16x8*)(qp + ks * 16);
  }
  f32x16 oacc[ND];
#pragma unroll
  for (int d = 0; d < ND; ++d)
#pragma unroll
    for (int i = 0; i < 16; ++i) oacc[d][i] = 0.f;
  float m_run = -1e30f, l_run = 0.f;
  u32x4 rk[KIT], rv[VIT];
#define ATT_GLOAD(key0) do { \
    _Pragma("unroll") for (int it = 0; it < KIT; ++it) { \
      const int c_ = tid + NTHR * it; const int krow_ = c_ / CPR; const int kcol_ = (c_ - krow_ * CPR) * 8; \
      const GAS bf16_t* src = (kcol_ < K0C) ? (k0g + (long)((key0) + krow_) * ldk0 + kcol_) : (k1g + (long)((key0) + krow_) * ldk1 + (kcol_ - K0C)); \
      rk[it] = *(const GAS u32x4*)src; } \
    _Pragma("unroll") for (int it = 0; it < VIT; ++it) { const int c = tid + NTHR * it; rv[it] = *(const GAS u32x4*)(vtg + (long)(c >> 3) * ldvt + (key0) + (c & 7) * 8); } } while (0)
#define ATT_LSTORE(buf) do { \
    bf16_t* dK = (bf16_t*)(smem + (buf) * BUFB); bf16_t* dV = (bf16_t*)(smem + (buf) * BUFB + KBYTES); \
    _Pragma("unroll") for (int it = 0; it < KIT; ++it) { const int c_ = tid + NTHR * it; const int krow_ = c_ / CPR; const int kcol_ = (c_ - krow_ * CPR) * 8; *(u32x4*)(dK + krow_ * LDK + kcol_) = rk[it]; } \
    _Pragma("unroll") for (int it = 0; it < VIT; ++it) { const int c = tid + NTHR * it; *(u32x4*)(dV + (c >> 3) * 72 + (c & 7) * 8) = rv[it]; } } while (0)
  __syncthreads();
  ATT_GLOAD(0);
  ATT_LSTORE(0);
  __syncthreads();
  const int ntiles = nkeys >> 6;
  for (int kt = 0; kt < ntiles; ++kt) {
    const int cur = kt & 1; const bool more = (kt + 1 < ntiles);
    if (more) ATT_GLOAD((kt + 1) * 64);
    const bf16_t* sK = (const bf16_t*)(smem + cur * BUFB); const bf16_t* sV = (const bf16_t*)(smem + cur * BUFB + KBYTES);
    f32x16 st[2];
#pragma unroll
    for (int i = 0; i < 16; ++i) { st[0][i] = 0.f; st[1][i] = 0.f; }
    const PG8_LAS bf16_t* kp = (const PG8_LAS bf16_t*)sK + r * LDK + h * 8;
    {
      bf16x8 c0 = *(const PG8_LAS bf16x8*)(kp), c1 = *(const PG8_LAS bf16x8*)(kp + 32 * LDK);
      __builtin_amdgcn_sched_barrier(0);
#pragma unroll
      for (int ks = 0; ks < NKS; ++ks) {
        bf16x8 e0 = c0, e1 = c1;
        if (ks + 1 < NKS) { e0 = *(const PG8_LAS bf16x8*)(kp + (ks + 1) * 16); e1 = *(const PG8_LAS bf16x8*)(kp + 32 * LDK + (ks + 1) * 16); }
        st[0] = MFMA32(c0, bq[ks], st[0]); st[1] = MFMA32(c1, bq[ks], st[1]);
        __builtin_amdgcn_sched_group_barrier(0x100, 2, 0); __builtin_amdgcn_sched_group_barrier(0x008, 2, 0);
        __builtin_amdgcn_sched_barrier(0);
        c0 = e0; c1 = e1;
      }
    }
    __builtin_amdgcn_sched_barrier(0);
    float mx = st[0][0];
#pragma unroll
    for (int i = 0; i < 16; ++i) { mx = fmaxf(mx, st[0][i]); mx = fmaxf(mx, st[1][i]); }
    mx = xmax32(mx);
    const float m_new = fmaxf(m_run, mx);
    const float alpha = __builtin_amdgcn_exp2f(m_run - m_new);
    m_run = m_new;
    float ls = 0.f;
#pragma unroll
    for (int i = 0; i < 16; ++i) { st[0][i] = __builtin_amdgcn_exp2f(st[0][i] - m_new); st[1][i] = __builtin_amdgcn_exp2f(st[1][i] - m_new); ls += st[0][i] + st[1][i]; }
    l_run = l_run * alpha + ls;
    if (__builtin_amdgcn_ballot_w64(alpha != 1.f) != 0ull) {
#pragma unroll
      for (int d = 0; d < ND; ++d)
#pragma unroll
        for (int i = 0; i < 16; ++i) oacc[d][i] *= alpha;
    }
    __builtin_amdgcn_sched_barrier(0);
    {
      bf16x8 pb[4];
#pragma unroll
      for (int s = 0; s < 4; ++s) {
        const int mi = s >> 1, sub = s & 1;
        u32x4 pp = {pack2(st[mi][8 * sub + 0], st[mi][8 * sub + 1]), pack2(st[mi][8 * sub + 2], st[mi][8 * sub + 3]),
                    pack2(st[mi][8 * sub + 4], st[mi][8 * sub + 5]), pack2(st[mi][8 * sub + 6], st[mi][8 * sub + 7])};
        pb[s] = __builtin_bit_cast(bf16x8, pp);
      }
      const PG8_LAS bf16_t* vb = (const PG8_LAS bf16_t*)sV + r * 72 + 4 * h;
      u32x2 lo = *(const PG8_LAS u32x2*)vb, hi = *(const PG8_LAS u32x2*)(vb + 8);
      __builtin_amdgcn_sched_barrier(0);
#pragma unroll
      for (int i_ = 0; i_ < 4 * ND; ++i_) {
        const int s = i_ / ND, d = i_ % ND;
        u32x2 nlo = lo, nhi = hi;
        if (i_ + 1 < 4 * ND) { const int s2 = (i_ + 1) / ND, d2 = (i_ + 1) % ND; const PG8_LAS bf16_t* vp = vb + d2 * 32 * 72 + s2 * 16; nlo = *(const PG8_LAS u32x2*)vp; nhi = *(const PG8_LAS u32x2*)(vp + 8); }
        u32x4 av = {lo[0], lo[1], hi[0], hi[1]};
        oacc[d] = MFMA32(__builtin_bit_cast(bf16x8, av), pb[s], oacc[d]);
        __builtin_amdgcn_sched_group_barrier(0x100, 2, 0); __builtin_amdgcn_sched_group_barrier(0x008, 1, 0);
        __builtin_amdgcn_sched_barrier(0);
        lo = nlo; hi = nhi;
      }
    }
    __builtin_amdgcn_sched_barrier(0);
    if (more) ATT_LSTORE(cur ^ 1);
    __syncthreads();
  }
#undef ATT_GLOAD
#undef ATT_LSTORE
  const float l_tot = xsum32(l_run);
  const float inv = 1.f / l_tot;
  const int tid2 = otid();
  GAS bf16_t* op = (GAS bf16_t*)o + (long)((tid2 >> 6) * 32 + (tid2 & 31)) * ldo;
#pragma unroll
  for (int d = 0; d < ND; ++d)
#pragma unroll
    for (int g = 0; g < 4; ++g) {
      u32x2 pk = {pack2(oacc[d][4 * g] * inv, oacc[d][4 * g + 1] * inv), pack2(oacc[d][4 * g + 2] * inv, oacc[d][4 * g + 3] * inv)};
      *(GAS u32x2*)(op + d * 32 + 8 * g + 4 * h) = pk;
    }
}

template <int RR>
DI void conv_step(float2 (&v)[8], const float2 (&wv)[31], const unsigned* sp) {
  const unsigned xx = sp[RR * 256];
  const float x0 = __uint_as_float(xx << 16), x1 = __uint_as_float(xx & 0xffff0000u);
#pragma unroll
  for (int t = 0; t < 8; ++t) {
    const int j = RR - t;
    if (j >= 0 && j < 31) { v[t].x += wv[j].x * x0; v[t].y += wv[j].y * x1; }
  }
  if constexpr ((RR & 3) == 3) __builtin_amdgcn_sched_barrier(0);
}
template <int... RR>
DI void conv_all(float2 (&v)[8], const float2 (&wv)[31], const unsigned* sp, std::integer_sequence<int, RR...>) { (conv_step<RR>(v, wv, sp), ...); }

DI void conv_unit(const bf16_t* __restrict__ hc, const float* __restrict__ cw, const float* __restrict__ cb, const float* __restrict__ lg, const float* __restrict__ lb,
                  bf16_t* __restrict__ yab, int b, int jt, unsigned char* smem, const int wv__) {
  bf16_t* sH = (bf16_t*)smem;
  float* sRed = (float*)(smem + 62 * 512 * 2);
  const int tid = otid(), lane = tid & 63, w = (tid >> 6) & 3, ch2 = tid & 255, hb = tid >> 8;
  __syncthreads();
  for (int c = tid; c < 62 * 64; c += NTHR) {
    const int row = c >> 6, kc = c & 63; const int pos = jt * 32 - 15 + row;
    u32x4 v = {0u, 0u, 0u, 0u};
    if (pos >= 0 && pos < SEQ) v = *(const u32x4*)(hc + ((size_t)b * SEQ + pos) * 512 + kc * 8);
    *(u32x4*)(sH + row * 512 + kc * 8) = v;
  }
  float2 wv[31];
#pragma unroll
  for (int j = 0; j < 31; ++j) wv[j] = *(const float2*)(cw + j * 512 + 2 * ch2);
  const float2 bias = *(const float2*)(cb + 2 * ch2);
  const float2 g2 = *(const float2*)(lg + 2 * ch2), b2 = *(const float2*)(lb + 2 * ch2);
  __syncthreads();
  const unsigned* sH32 = (const unsigned*)sH;
#pragma unroll 1
  for (int tgi = 0; tgi < 2; ++tgi) {
    const int tg = hb * 2 + tgi;
    float2 v[8];
#pragma unroll
    for (int t = 0; t < 8; ++t) v[t] = bias;
    conv_all(v, wv, sH32 + tg * 8 * 256 + ch2, std::make_integer_sequence<int, 38>{});
#pragma unroll
    for (int t = 0; t < 8; ++t) {
      float s1 = v[t].x + v[t].y, s2 = v[t].x * v[t].x + v[t].y * v[t].y;
      s1 = wsum64(s1); s2 = wsum64(s2);
      if (lane == 0) { sRed[((tg * 4 + w) * 8 + t) * 2] = s1; sRed[((tg * 4 + w) * 8 + t) * 2 + 1] = s2; }
    }
    __syncthreads();
#pragma unroll
    for (int t = 0; t < 8; ++t) {
      float s1 = 0.f, s2 = 0.f;
#pragma unroll
      for (int ww = 0; ww < 4; ++ww) { s1 += sRed[((tg * 4 + ww) * 8 + t) * 2]; s2 += sRed[((tg * 4 + ww) * 8 + t) * 2 + 1]; }
      const float mean = s1 * (1.f / 512.f); const float var = fmaxf(s2 * (1.f / 512.f) - mean * mean, 0.f);
      const float rs = rsqrtf(var + EPS);
      float y0 = (v[t].x - mean) * rs * g2.x + b2.x, y1 = (v[t].y - mean) * rs * g2.y + b2.y;
      y0 = y0 * sigmoidf_(y0); y1 = y1 * sigmoidf_(y1);
      *(unsigned*)(yab + ((size_t)b * SEQ + jt * 32 + tg * 8 + t) * 1024 + 512 + 2 * ch2) = pack2(y0, y1);
    }
  }
}

enum { WM_ID = 0, WM_GLU, WM_MLAINP, WM_QBP, WM_KVS };
DI void wconv_job(const float* __restrict__ src0, const float* __restrict__ src1, int lds_, const float* __restrict__ g, bf16_t* __restrict__ dst, int Nd, int K, int mode, int moff,
                  unsigned char* smem, int shift, const int wv__) {
  float* sT = (float*)smem;
  const int G = gridDim.x;
  const int kt_n = K >> 7; const int total = (Nd >> 6) * kt_n;
  for (int u = (int)((blockIdx.x + G - (shift % G)) % G); u < total; u += G) {
    const int tid = otid();
    const int tnn = u / kt_n, tk = u - tnn * kt_n;
    const int n = tnn * 64 + (tid & 63);
    const float* sp = src0; int sc = n;
    if (mode == WM_GLU) { const int tl = n >> 8, i = n & 255; if (i < 128) sc = tl * 128 + i; else { sc = tl * 128 + i - 128; sp = src1; } }
    else if (mode == WM_MLAINP) { if (n >= 832) sc = -1; else if (n >= 768) { const int p = n - 768; sc = 768 + (p >> 1) + (p & 1) * 32; } }
    else if (mode == WM_QBP) { const int hh = n / 192, c = n - hh * 192; if (c >= 128) { const int p = c - 128; sc = hh * 192 + 128 + (p >> 1) + (p & 1) * 32; } }
    else if (mode == WM_KVS) { sc = (n >> 7) * 256 + moff + (n & 127); }
    float v[16];
    const int k0 = tk * 128 + (tid >> 6);
#pragma unroll
    for (int i = 0; i < 16; ++i) v[i] = (sc >= 0) ? sp[(size_t)(k0 + 8 * i) * lds_ + sc] : 0.f;
    if (g) {
#pragma unroll
      for (int i = 0; i < 16; ++i) v[i] *= g[k0 + 8 * i];
    }
    __syncthreads();
#pragma unroll
    for (int i = 0; i < 16; ++i) sT[((tid >> 6) + 8 * i) * 65 + (tid & 63)] = v[i];
    __syncthreads();
    const int nl = tid >> 3, kc = (tid & 7) * 16;
    float w[16];
#pragma unroll
    for (int j = 0; j < 16; ++j) w[j] = sT[(kc + j) * 65 + nl];
    bf16_t* dp = dst + (size_t)(tnn * 64 + nl) * K + tk * 128 + kc;
    *(u32x4*)dp = pk8(w); *(u32x4*)(dp + 8) = pk8(w + 8);
  }
}
DI void wpq_job(const float* __restrict__ win, const float* __restrict__ gm, bf16_t* __restrict__ dst, unsigned char* smem, const int wv__) {
  float* sW = (float*)smem;
  float* tab = sW + 64 * 129;
  const int G = gridDim.x;
  for (int u = blockIdx.x; u < 256; u += G) {
    const int tid = otid();
    const int kt = u >> 4, gq = (u >> 2) & 3, jq = u & 3;
    __syncthreads();
    if (tid < 128) tab[tid] = __builtin_amdgcn_cosf((float)tid * (1.f / 128.f));
    for (int c = tid; c < 64 * 128; c += NTHR) { const int kk = c >> 7, cc = c & 127; sW[kk * 129 + cc] = win[(size_t)(kt * 64 + kk) * 1536 + gq * 128 + cc]; }
    __syncthreads();
    const int kk = tid & 63; const float gk = gm[kt * 64 + kk];
    for (int i = 0; i < 4; ++i) {
      const int j = (tid >> 6) + 8 * (i + 4 * jq);
      float p = 0.f, qv = 0.f;
      for (int c = 0; c < 128; ++c) { const float wv = sW[kk * 129 + c]; const int m = (c * j) & 127; p += wv * tab[m]; qv += wv * tab[(m - 32) & 127]; }
      dst[(size_t)(gq * 128 + j) * 1024 + kt * 64 + kk] = f2bf(p * gk);
      dst[(size_t)(512 + gq * 128 + j) * 1024 + kt * 64 + kk] = f2bf(qv * gk);
    }
  }
}

#define XB_TMO      128
#define XB_XCNT(j)  (256  + 64 * (j))
#define XB_XSUB(j)  (1280 + 64 * (j))
#define XB_XGEN(j)  (2304 + 64 * (j))
#define XB_TOP      3328
#define XB_TOPGEN   3392
#define XCD_BAR_WORDS 3456
#define XB_SPIN_CAP (1u << 20)
DI unsigned xb_ld(unsigned* p)              { return __hip_atomic_load(p, __ATOMIC_RELAXED, __HIP_MEMORY_SCOPE_AGENT); }
DI unsigned xb_add(unsigned* p, unsigned v) { return __hip_atomic_fetch_add(p, v, __ATOMIC_RELAXED, __HIP_MEMORY_SCOPE_AGENT); }
DI unsigned xb_xcc_id() { return (unsigned)__builtin_amdgcn_s_getreg((3 << 11) | 20) & 0xFu; }
#define XB_SPIN(cond, bar) do { unsigned _sp = 0; while (cond) { __builtin_amdgcn_s_sleep(1); \
    if ((++_sp & 255u) == 0u) { if (xb_ld(&(bar)[XB_TMO])) break; if (_sp > XB_SPIN_CAP) { atomicAdd(&(bar)[XB_TMO], 1u); break; } } } } while (0)
struct XcdBarrier { unsigned* bar; unsigned x; volatile PG8_LAS unsigned* st; };
DI XcdBarrier xcd_barrier_post(unsigned* bar, volatile PG8_LAS unsigned* st) {
    XcdBarrier b; b.bar = bar; b.x = xb_xcc_id(); b.st = st;
    if (threadIdx.x == 0) { const unsigned rank = xb_add(&bar[XB_XCNT(b.x)], 1u); st[2] = rank; st[3] = b.x; }
    return b;
}
DI void xcd_barrier_complete(unsigned* bar, unsigned x, unsigned& nloc, unsigned& nx) {
    const unsigned G = gridDim.x * gridDim.y * gridDim.z;
    unsigned sum, cnt, mine, sp = 0u;
    for (;;) {
        sum = 0u; cnt = 0u; mine = 0u;
#pragma unroll
        for (unsigned j = 0; j < 16; ++j) { const unsigned c = xb_ld(&bar[XB_XCNT(j)]); sum += c; cnt += (c > 0u) ? 1u : 0u; mine = (j == x) ? c : mine; }
        if (sum == G) break;
        __builtin_amdgcn_s_sleep(1);
        if ((++sp & 255u) == 0u) { if (xb_ld(&bar[XB_TMO])) break; if (sp > XB_SPIN_CAP) { atomicAdd(&bar[XB_TMO], 1u); break; } }
    }
    nloc = mine > 0u ? mine : 1u; nx = cnt > 0u ? cnt : 1u;
}
DI void xcd_barrier(const XcdBarrier& b, const int wv__) {
    asm volatile("s_waitcnt vmcnt(0)" ::: "memory");
    __syncthreads();
    if (is_t0()) {
        unsigned* bar = b.bar;
        __builtin_amdgcn_s_waitcnt(0);
        unsigned nloc = b.st[0], nx = b.st[1];
        if (nloc == 0u) { xcd_barrier_complete(bar, b.x, nloc, nx); b.st[0] = nloc; b.st[1] = nx; }
        const unsigned old = xb_add(&bar[XB_XSUB(b.x)], 1u);
        const unsigned gen = old / nloc;
        if (old + 1u == (gen + 1u) * nloc) {
            __builtin_amdgcn_fence(__ATOMIC_RELEASE, "agent");
            asm volatile("s_waitcnt vmcnt(0)" ::: "memory");
            const unsigned og = xb_add(&bar[XB_TOP], 1u);
            const unsigned tg = og / nx;
            if (og + 1u == (tg + 1u) * nx) xb_add(&bar[XB_TOPGEN], 1u);
            else XB_SPIN(xb_ld(&bar[XB_TOPGEN]) == tg, bar);
            __builtin_amdgcn_fence(__ATOMIC_ACQUIRE, "agent");
            xb_add(&bar[XB_XGEN(b.x)], 1u);
            asm volatile("s_waitcnt vmcnt(0)" ::: "memory");
        } else {
            XB_SPIN(xb_ld(&bar[XB_XGEN(b.x)]) == gen, bar);
            __builtin_amdgcn_fence(__ATOMIC_ACQUIRE, "agent");
            asm volatile("s_waitcnt vmcnt(0)" ::: "memory");
        }
    }
    __syncthreads();
}

#define XB ((bf16_t*)(wsb + OFF_XB))
#define SSQ ((float*)(wsb + OFF_SSQ))
#define ROPE ((const float2*)(wsb + OFF_ROPE))
#define DFT ((bf16_t*)(wsb + OFF_DFT))
#define MEMN ((bf16_t*)(wsb + OFF_MEMN))
#define MEMK ((bf16_t*)(wsb + OFF_MEMK))
#define MEMVT ((bf16_t*)(wsb + OFF_MEMVT))
#define RR_ (wsb + OFF_R)
#define WGU1 ((bf16_t*)(wsb + OFF_WGU1))
#define WD1 ((bf16_t*)(wsb + OFF_WD1))
#define WGU2 ((bf16_t*)(wsb + OFF_WGU2))
#define WD2 ((bf16_t*)(wsb + OFF_WD2))
#define WXQ ((bf16_t*)(wsb + OFF_WXQ))
#define WXKV ((bf16_t*)(wsb + OFF_WXKV))
#define WXO ((bf16_t*)(wsb + OFF_WXO))
#define WMIX (wsb + OFF_WMIX)
#define SITE(s) (SSQ + (size_t)((s) & 3) * SLOT)
#define SQQ (SSQ + (size_t)(4 + 2 * li) * SLOT)
#define SQKV (SSQ + (size_t)(5 + 2 * li) * SLOT)
#define PQT ((bf16_t*)(RR_ + R_PQT))
#define HC ((bf16_t*)(RR_ + R_HCONV))
#define YAB ((bf16_t*)(RR_ + R_YAB))
#define UU ((bf16_t*)(RR_ + R_U))
#define QQ ((bf16_t*)(RR_ + R_Q))
#define KN ((bf16_t*)(RR_ + R_KN))
#define VT ((bf16_t*)(RR_ + R_VT))
#define OO ((bf16_t*)(RR_ + R_O))
#define QX ((bf16_t*)(RR_ + R_QX))
#define OX ((bf16_t*)(RR_ + R_OX))

__global__ void __launch_bounds__(NTHR, 2) fwd_kernel(Params P) {
  extern __shared__ __attribute__((aligned(16))) unsigned char smem[];
  cg::grid_group grid = cg::this_grid();
  const int G = gridDim.x, bid = blockIdx.x;
  const int pb = P.pb, pe = P.pe;
  const int wv__ = __builtin_amdgcn_readfirstlane((int)(threadIdx.x >> 6));
  volatile PG8_LAS unsigned* xbst = (volatile PG8_LAS unsigned*)((PG8_LAS unsigned char*)smem + LDS_STAGE);
  if (threadIdx.x == 0) { xbst[0] = 0u; xbst[1] = 0u; }
  __syncthreads();
  const XcdBarrier xbar = xcd_barrier_post((unsigned*)(P.ws + OFF_BAR), xbst);
  int ph = 0;
#define PH_BEGIN if (ph >= pb && ph < pe) { unsigned char* wsb = opq(P.ws); float* X = (float*)opq((unsigned char*)P.out); const int tid = otid(); const int lane = tid & 63; (void)lane; (void)X; (void)wsb;
#define PH_END } ++ph; if (ph > pb && ph < pe) { if (ph == 1) { grid.sync(); \
      if (is_t0()) { const unsigned rank = xbst[2], x = xbst[3]; const unsigned per = (unsigned)G / 8u; bool okx = ((unsigned)G % 8u == 0u); \
        for (unsigned j = 0; j < 16; ++j) { const unsigned c_ = xb_ld((unsigned*)(P.ws + OFF_BAR) + XB_XCNT(j)); okx = okx && (c_ == (j < 8u ? per : 0u)); } \
        xbst[2] = okx ? rank * 8u + x : (unsigned)bid;         \
        xbst[3] = okx ? x * per + rank : (unsigned)bid; }      \
      __syncthreads(); } else xcd_barrier(xbar, wv__); }

  for (int l = 0; l < 4; ++l) {
    const int li = l >> 1; const bool even = ((l & 1) == 0);
    PH_BEGIN
      if (even) wpq_job(P.in[18] + (size_t)li * 1024 * 1536, P.in[8] + l * 1024, (bf16_t*)(WMIX + WM_ABIN), smem, wv__);
      if (l == 0) {
        const int wv = tid >> 6;
        for (int row = bid * NWV + wv; row < T; row += G * NWV) {
          const float* src = (row < 16384) ? (P.in[0] + (size_t)row * 1024) : (P.in[1] + (size_t)(row - 16384) * 1024);
          float ss = 0.f;
#pragma unroll
          for (int i = 0; i < 4; ++i) {
            const int c = (i * 64 + lane) * 4;
            const float4 v = *(const float4*)(src + c);
            u32x2 pk = {pack2(v.x, v.y), pack2(v.z, v.w)};
            *(u32x2*)(XB + (size_t)row * 1024 + c) = pk;
            const float r0 = __uint_as_float(pk[0] << 16), r1 = __uint_as_float(pk[0] & 0xffff0000u), r2 = __uint_as_float(pk[1] << 16), r3 = __uint_as_float(pk[1] & 0xffff0000u);
            ss += r0 * r0 + r1 * r1 + r2 * r2 + r3 * r3;
          }
          ss = wsum64(ss);
          if (lane < 16) SITE(0)[(size_t)row * 16 + lane] = (lane == 0) ? ss : 0.f;
        }
        for (size_t i = (size_t)bid * NTHR + tid; i < 4 * SLOT; i += (size_t)G * NTHR) SSQ[4 * SLOT + i] = 0.f;
        for (int row = bid * NWV + wv; row < MEMT; row += G * NWV) {
          const float* src = (row < 2048) ? (P.in[2] + (size_t)row * 1024) : (P.in[3] + (size_t)(row - 2048) * 1024);
          float4 v[4]; float ss = 0.f;
#pragma unroll
          for (int i = 0; i < 4; ++i) { v[i] = *(const float4*)(src + (i * 64 + lane) * 4); ss += v[i].x * v[i].x + v[i].y * v[i].y + v[i].z * v[i].z + v[i].w * v[i].w; }
          ss = wsum64(ss);
          const float rs = rsqrtf(ss * (1.f / 1024.f) + EPS);
#pragma unroll
          for (int i = 0; i < 4; ++i) { u32x2 pk = {pack2(v[i].x * rs, v[i].y * rs), pack2(v[i].z * rs, v[i].w * rs)}; *(u32x2*)(MEMN + (size_t)row * 1024 + (i * 64 + lane) * 4) = pk; }
        }
        for (int i = bid * NTHR + tid; i < 2048 * 32; i += G * NTHR) {
          const int pos = i >> 5, fi = i & 31;
          const float inv_freq = __builtin_amdgcn_exp2f(-13.287712379549449f * (float)(2 * fi) * (1.f / 64.f));
          const float ang = (float)pos * inv_freq;
          const float kq = rintf(ang * 0.15915494309189535f);
          float rem = fmaf(-kq, 6.28125f, ang); rem = fmaf(-kq, 1.9353071795864769e-3f, rem);
          const float rev = rem * 0.15915494309189535f;
          ((float2*)(wsb + OFF_ROPE))[i] = make_float2(__builtin_amdgcn_cosf(rev), __builtin_amdgcn_sinf(rev));
        }
        for (int i = bid * NTHR + tid; i < 2048 * 2048; i += G * NTHR) {
          const int s = i >> 11, t = i & 2047;
          const int m = (s * t) & 2047;
          const float rev = (float)m * (1.f / 2048.f);
          DFT[(size_t)s * 4096 + t] = f2bf(__builtin_amdgcn_cosf(rev));
          DFT[(size_t)s * 4096 + 2048 + t] = f2bf(-__builtin_amdgcn_sinf(rev));
        }
      }
      {
        const size_t o_gu = (size_t)l * 1024 * 2816, o_sq = (size_t)l * 1024 * 1024;
        wconv_job(P.in[5] + o_gu, P.in[6] + o_gu, 2816, P.in[4] + l * 1024, WGU1, 5632, 1024, WM_GLU, 0, smem, 0, wv__);
        wconv_job(P.in[7] + o_gu, nullptr, 1024, nullptr, WD1, 1024, 2816, WM_ID, 0, smem, 704, wv__);
        wconv_job(P.in[15] + o_gu, P.in[16] + o_gu, 2816, P.in[14] + l * 1024, WGU2, 5632, 1024, WM_GLU, 0, smem, 1056, wv__);
        wconv_job(P.in[17] + o_gu, nullptr, 1024, nullptr, WD2, 1024, 2816, WM_ID, 0, smem, 1760, wv__);
        wconv_job(P.in[11] + o_sq, nullptr, 1024, P.in[9] + l * 1024, WXQ, 1024, 1024, WM_ID, 0, smem, 2112, wv__);
        wconv_job(P.in[12] + 2 * o_sq, nullptr, 2048, P.in[10] + l * 1024, WXKV, 2048, 1024, WM_ID, 0, smem, 2240, wv__);
        wconv_job(P.in[13] + o_sq, nullptr, 1024, nullptr, WXO, 1024, 1024, WM_ID, 0, smem, 2496, wv__);
        if (even) {
          const float* win = P.in[18] + (size_t)li * 1024 * 1536;
          wconv_job(win + 512, win + 1024, 1536, P.in[8] + l * 1024, (bf16_t*)(WMIX + WM_ABIN) + (size_t)1024 * 1024, 1024, 1024, WM_GLU, 0, smem, 2624, wv__);
          wconv_job(P.in[23] + (size_t)li * 1024 * 1024, nullptr, 1024, nullptr, (bf16_t*)(WMIX + WM_ABOUT), 1024, 1024, WM_ID, 0, smem, 2752, wv__);
        } else {
          wconv_job(P.in[24] + (size_t)li * 1024 * 832, nullptr, 832, P.in[8] + l * 1024, (bf16_t*)(WMIX + WM_MLAIN), 1024, 1024, WM_MLAINP, 0, smem, 2624, wv__);
          wconv_job(P.in[26] + (size_t)li * 512 * 1536, nullptr, 1536, P.in[25] + li * 512, (bf16_t*)(WMIX + WM_QB), 1536, 512, WM_QBP, 0, smem, 2752, wv__);
          wconv_job(P.in[28] + (size_t)li * 256 * 2048, nullptr, 2048, P.in[27] + li * 256, (bf16_t*)(WMIX + WM_KN), 1024, 256, WM_KVS, 0, smem, 2848, wv__);
          wconv_job(P.in[28] + (size_t)li * 256 * 2048, nullptr, 2048, P.in[27] + li * 256, (bf16_t*)(WMIX + WM_V), 1024, 256, WM_KVS, 128, smem, 2880, wv__);
          wconv_job(P.in[29] + (size_t)li * 1024 * 1024, nullptr, 1024, nullptr, (bf16_t*)(WMIX + WM_MLAOUT), 1024, 1024, WM_ID, 0, smem, 2912, wv__);
        }
      }
    PH_END

    PH_BEGIN
      { EpiArgs e{}; e.p0 = RR_; e.i0 = FF; e.ssq = SITE(4 * l + 0); e.f1 = 1.f / 1024.f;
        gemm_job_<EPI_SWIGLU>(XB, 1024, WGU1, 1024, T, 5632, 1024, e, smem, 0, wv__); }
      { EpiArgs e{}; e.p0 = MEMK; e.i0 = 1024; e.ssq = nullptr; e.f0 = 1.f;
        gemm_job_<EPI_STORE>(MEMN, 1024, WXKV, 1024, MEMT, 1024, 1024, e, smem, 4224, wv__); }
      { EpiArgs e{}; e.p0 = MEMVT;
        gemm_job_<EPI_MEMVT>(WXKV + (size_t)1024 * 1024, 1024, MEMN, 1024, 1024, MEMT, 1024, e, smem, 4224 + 96, wv__); }
    PH_END
    PH_BEGIN
      { EpiArgs e{}; e.p0 = X; e.p1 = XB; e.p2 = SITE(4 * l + 1); e.f0 = 0.5f;
        gemm_job_<EPI_RESID>((const bf16_t*)RR_, FF, WD1, FF, T, 1024, FF, e, smem, 0, wv__); }
    PH_END

    if (even) {
      PH_BEGIN
        { EpiArgs e{}; e.p0 = PQT; e.ssq = SITE(4 * l + 1); e.f1 = 1.f / 1024.f;
          gemm_job_<EPI_PQT>((const bf16_t*)(WMIX + WM_ABIN), 1024, XB, 1024, 1024, T, 1024, e, smem, 0, wv__); }
        { EpiArgs e{}; e.p0 = HC; e.i0 = 512; e.ssq = SITE(4 * l + 1); e.f1 = 1.f / 1024.f;
          gemm_job_<EPI_GLUAB>(XB, 1024, (const bf16_t*)(WMIX + WM_ABIN) + (size_t)1024 * 1024, 1024, T, 1024, 1024, e, smem, 0, wv__); }
      PH_END
      PH_BEGIN
        { EpiArgs e{}; e.p0 = YAB; e.f0 = 1.f / 512.f;
          gemm_job_<EPI_FOUR>(DFT, 4096, PQT, 4096, 2048, NSEQ * 512, 4096, e, smem, 0, wv__); }
        {
          const float* cw = P.in[19] + (size_t)li * 31 * 512; const float* cb = P.in[20] + li * 512;
          const float* lg = P.in[21] + li * 512; const float* lb = P.in[22] + li * 512;
          const int cidc = __builtin_amdgcn_readfirstlane((int)xbst[2]);
          if (G == 256) { if (cidc >= 128) for (int u = cidc - 128; u < NSEQ * 64; u += 128) conv_unit(HC, cw, cb, lg, lb, YAB, u >> 6, u & 63, smem, wv__); }
          else for (int u = bid; u < NSEQ * 64; u += G) conv_unit(HC, cw, cb, lg, lb, YAB, u >> 6, u & 63, smem, wv__);
        }
      PH_END
      PH_BEGIN
        { EpiArgs e{}; e.p0 = X; e.p1 = XB; e.p2 = SITE(4 * l + 2); e.f0 = 1.f;
          gemm_job_<EPI_RESID>(YAB, 1024, (const bf16_t*)(WMIX + WM_ABOUT), 1024, T, 1024, 1024, e, smem, 0, wv__); }
      PH_END
    } else {
      PH_BEGIN
        { EpiArgs e{}; e.p0 = UU; e.p1 = SQQ; e.p2 = SQKV; e.ssq = SITE(4 * l + 1); e.f1 = 1.f / 1024.f; e.rope = ROPE;
          gemm_job_<EPI_MLAIN>(XB, 1024, (const bf16_t*)(WMIX + WM_MLAIN), 1024, T, 1024, 1024, e, smem, 0, wv__); }
      PH_END
      for (int pt = 0; pt < 3; ++pt) {
        const size_t ro = (size_t)pt * PT;
        PH_BEGIN
          if (pt > 0) { const size_t rp = ro - PT;
            EpiArgs e{}; e.p0 = X + rp * 1024; e.p1 = XB + rp * 1024; e.p2 = SITE(4 * l + 2) + rp * 16; e.f0 = 1.f;
            gemm_job_<EPI_RESID>(OO, 1024, (const bf16_t*)(WMIX + WM_MLAOUT), 1024, PT, 1024, 1024, e, smem, 0, wv__); }
          { EpiArgs e{}; e.p0 = QQ; e.ssq = SQQ + ro * 16; e.f1 = 1.f / 512.f; e.f0 = 1.4426950408889634f * 0.07216878364870322f; e.rope = ROPE;
            gemm_job_<EPI_Q>(UU + ro * 896, 896, (const bf16_t*)(WMIX + WM_QB), 512, PT, 1536, 512, e, smem, 0, wv__); }
          { EpiArgs e{}; e.p0 = KN; e.i0 = 1024; e.ssq = SQKV + ro * 16; e.f1 = 1.f / 256.f; e.f0 = 1.f;
            gemm_job_<EPI_STORE>(UU + ro * 896 + 512, 896, (const bf16_t*)(WMIX + WM_KN), 256, PT, 1024, 256, e, smem, -128, wv__); }
          { EpiArgs e{}; e.p0 = VT; e.ssq = SQKV + ro * 16; e.f1 = 1.f / 256.f;
            gemm_job_<EPI_VT>((const bf16_t*)(WMIX + WM_V), 256, UU + ro * 896 + 512, 896, 1024, PT, 256, e, smem, 0, wv__); }
        PH_END
        PH_BEGIN
          for (int u = __builtin_amdgcn_readfirstlane((int)xbst[3]); u < 8 * 8 * 8; u += G) {
            const int qt = u & 7, hh = (u >> 3) & 7, b = u >> 6;
            attn_unit<192, 128, 128>(QQ + ((size_t)b * 2048 + qt * 256) * 1536 + hh * 192, 1536,
                                     KN + (size_t)b * 2048 * 1024 + hh * 128, 1024, UU + (ro + (size_t)b * 2048) * 896 + 768, 896,
                                     VT + ((size_t)(b * 8 + hh) * 128) * 2048, 2048, 2048,
                                     OO + ((size_t)b * 2048 + qt * 256) * 1024 + hh * 128, 1024, smem, wv__);
          }
        PH_END
      }
      PH_BEGIN
        { const size_t rp = (size_t)2 * PT;
          EpiArgs e{}; e.p0 = X + rp * 1024; e.p1 = XB + rp * 1024; e.p2 = SITE(4 * l + 2) + rp * 16; e.f0 = 1.f;
          gemm_job_<EPI_RESID>(OO, 1024, (const bf16_t*)(WMIX + WM_MLAOUT), 1024, PT, 1024, 1024, e, smem, 0, wv__); }
      PH_END
    }

    PH_BEGIN
      { EpiArgs e{}; e.p0 = QX; e.i0 = 1024; e.ssq = SITE(4 * l + 2); e.f1 = 1.f / 1024.f; e.f0 = 1.4426950408889634f * 0.0625f;
        gemm_job_<EPI_STORE>(XB, 1024, WXQ, 1024, T, 1024, 1024, e, smem, 0, wv__); }
    PH_END
    PH_BEGIN
      for (int u = __builtin_amdgcn_readfirstlane((int)xbst[3]); u < NSEQ * 4 * 2 * 8; u += G) {
        const int qt = u & 7, dvc = (u >> 3) & 1, hh = (u >> 4) & 3, b = u >> 6;
        attn_unit<256, 256, 128>(QX + ((size_t)b * 2048 + qt * 256) * 1024 + hh * 256, 1024,
                                MEMK + (size_t)b * 256 * 1024 + hh * 256, 1024, nullptr, 0,
                                MEMVT + ((size_t)(b * 4 + hh) * 256 + dvc * 128) * 256, 256, 256,
                                OX + ((size_t)b * 2048 + qt * 256) * 1024 + hh * 256 + dvc * 128, 1024, smem, wv__);
      }
    PH_END
    PH_BEGIN
      { EpiArgs e{}; e.p0 = X; e.p1 = XB; e.p2 = SITE(4 * l + 3); e.f0 = 1.f;
        gemm_job_<EPI_RESID>(OX, 1024, WXO, 1024, T, 1024, 1024, e, smem, 0, wv__); }
    PH_END
    PH_BEGIN
      { EpiArgs e{}; e.p0 = RR_; e.i0 = FF; e.ssq = SITE(4 * l + 3); e.f1 = 1.f / 1024.f;
        gemm_job_<EPI_SWIGLU>(XB, 1024, WGU2, 1024, T, 5632, 1024, e, smem, 0, wv__); }
    PH_END
    PH_BEGIN
      { EpiArgs e{}; e.p0 = X; e.p1 = XB; e.p2 = SITE(4 * l + 4); e.f0 = 0.5f;
        gemm_job_<EPI_RESID>((const bf16_t*)RR_, FF, WD2, FF, T, 1024, FF, e, smem, 0, wv__); }
    PH_END
  }
  PH_BEGIN
    {
      const int wv = tid >> 6; const float* fg = P.in[30]; const float* sq = SITE(16);
      for (int row = bid * NWV + wv; row < T; row += G * NWV) {
        const float rs = rstd16(sq, (size_t)row, 1.f / 1024.f);
#pragma unroll
        for (int i = 0; i < 4; ++i) {
          const int c = (i * 64 + lane) * 4;
          const u32x2 xv = *(const u32x2*)(XB + (size_t)row * 1024 + c); const float4 g = *(const float4*)(fg + c);
          float4 v;
          v.x = __uint_as_float(xv[0] << 16) * rs * g.x; v.y = __uint_as_float(xv[0] & 0xffff0000u) * rs * g.y;
          v.z = __uint_as_float(xv[1] << 16) * rs * g.z; v.w = __uint_as_float(xv[1] & 0xffff0000u) * rs * g.w;
          *(float4*)(X + (size_t)row * 1024 + c) = v;
        }
      }
    }
  PH_END
#undef PH_BEGIN
#undef PH_END
}

constexpr int NPHASES = 2 * 11 + 2 * 16 + 1;

extern "C" void kernel_launch(void* const* d_in, const int* in_sizes, int n_in, void* d_out, int out_size, void* d_ws, size_t ws_size, hipStream_t stream) {
  static int grid_blocks = 0;
  if (grid_blocks == 0) {
    if (n_in != 31 || ws_size < WS_NEED) { fprintf(stderr, "kernel_launch: bad n_in %d or ws_size %zu < %zu\n", n_in, ws_size, (size_t)WS_NEED); grid_blocks = -1; return; }
    int dev = 0, cus = 0, per_cu = 0;
    (void)hipGetDevice(&dev);
    (void)hipDeviceGetAttribute(&cus, hipDeviceAttributeMultiprocessorCount, dev);
    if (hipFuncSetAttribute((const void*)fwd_kernel, hipFuncAttributeMaxDynamicSharedMemorySize, LDS_BYTES) != hipSuccess) { fprintf(stderr, "hipFuncSetAttribute failed\n"); grid_blocks = -1; return; }
    (void)hipOccupancyMaxActiveBlocksPerMultiprocessor(&per_cu, (const void*)fwd_kernel, NTHR, LDS_BYTES);
    if (per_cu < 1) { fprintf(stderr, "occupancy query says %d\n", per_cu); per_cu = 1; }
    grid_blocks = cus;
    fprintf(stderr, "kernel_launch: cus %d per_cu %d grid %d\n", cus, per_cu, grid_blocks);
  }
  if (grid_blocks < 0) return;
  Params p{};
  for (int i = 0; i < 31; ++i) p.in[i] = (const float*)d_in[i];
  p.out = (float*)d_out; p.ws = (unsigned char*)d_ws;
  if (hipMemsetAsync((char*)d_ws + OFF_BAR, 0, 16384, stream) != hipSuccess) { fprintf(stderr, "memset of barrier words failed\n"); return; }
  p.pb = 0; p.pe = NPHASES;
  void* args[] = {&p};
  hipError_t e = hipLaunchCooperativeKernel((const void*)fwd_kernel, dim3(grid_blocks), dim3(NTHR), args, LDS_BYTES, stream);
  if (e != hipSuccess) fprintf(stderr, "cooperative launch failed: %s (grid %d)\n", hipGetErrorString(e), grid_blocks);
}
```
